# Optimizing an MI355X kernel written in HIP

```python
import jax, jax.numpy as jnp
from jax import lax
import numpy as np

D_MODEL = 4096
BATCH = 1
SEQ = 8192
DEPTH = 1

CHUNK = 64
Q_BLOCK = 128
N_MEM = 256
SB_HEADS = 12
SB_HEAD_DIM = 128
SB_W = SB_HEADS * SB_HEAD_DIM
MLA_HEADS = 12
Q_LORA = 896
KV_LORA = 512
NOPE_DIM = 128
ROPE_DIM = 64
V_DIM = 128
QK_DIM = NOPE_DIM + ROPE_DIM
MLA_W = MLA_HEADS * V_DIM
MEM_HEADS = 4
MEM_HEAD_DIM = 256
MEM_W = MEM_HEADS * MEM_HEAD_DIM
N_BRANCH = 3
D_FF = 4 * D_MODEL
ROPE_THETA = 10000.0
EPS = 1e-6
IN_SIZES = (SB_W, SB_W, SB_W, Q_LORA, KV_LORA, ROPE_DIM, MEM_W, N_BRANCH * D_MODEL)
N_IN = SB_W * 3 + Q_LORA + KV_LORA + ROPE_DIM + MEM_W + N_BRANCH * D_MODEL

kernel_name = "chunk_causal_hybrid_sb_mla_mem_block"


def rmsnorm(x, g):
    xf = x.astype(jnp.float32)
    y = xf * lax.rsqrt(jnp.mean(xf * xf, axis=-1, keepdims=True) + EPS)
    return (y * g.astype(jnp.float32)).astype(x.dtype)


def to_heads(t, n_heads):
    b, s, _ = t.shape
    return t.reshape(b, s, n_heads, -1).transpose(0, 2, 1, 3)


def merge_heads(t):
    b, h, s, d = t.shape
    return t.transpose(0, 2, 1, 3).reshape(b, s, h * d)


def rope(t, positions):
    half = t.shape[-1] // 2
    freqs = 1.0 / (ROPE_THETA ** (jnp.arange(half, dtype=jnp.float32) / half))
    ang = positions.astype(jnp.float32)[..., None] * freqs
    if t.ndim == 4:
        ang = ang[:, None]
    cos, sin = jnp.cos(ang), jnp.sin(ang)
    tf = t.astype(jnp.float32)
    t1, t2 = tf[..., :half], tf[..., half:]
    return jnp.concatenate([t1 * cos - t2 * sin, t2 * cos + t1 * sin], axis=-1).astype(t.dtype)


def sweep_query_blocks(block_fn, q):
    b, h, s, d = q.shape
    nb = s // Q_BLOCK
    qb = q.reshape(b, h, nb, Q_BLOCK, d).transpose(2, 0, 1, 3, 4)
    starts = jnp.arange(nb, dtype=jnp.int32) * Q_BLOCK
    out = lax.map(block_fn, (qb, starts))
    return out.transpose(1, 2, 0, 3, 4).reshape(b, h, s, -1)


def stick_breaking_attention(q, k, v):
    s_len = k.shape[2]
    scale = 1.0 / np.sqrt(q.shape[-1]).astype(np.float32)
    key_pos = jnp.arange(s_len, dtype=jnp.int32)

    def block(args):
        qb, t0 = args
        z = jnp.einsum('bhqd,bhkd->bhqk', qb, k).astype(jnp.float32) * scale
        t = t0 + jnp.arange(Q_BLOCK, dtype=jnp.int32)
        causal = key_pos[None, :] < t[:, None]
        l = jnp.where(causal, jax.nn.log_sigmoid(-z), 0.0)
        rev = lax.cumsum(l, axis=3, reverse=True)
        log_a = jax.nn.log_sigmoid(z) + rev - l
        a = jnp.where(causal, jnp.exp(log_a), 0.0)
        return jnp.einsum('bhqk,bhkd->bhqd', a.astype(v.dtype), v)

    return sweep_query_blocks(block, q)


def chunk_causal_softmax_attention(q, k, v):
    s_len = k.shape[2]
    scale = 1.0 / np.sqrt(q.shape[-1]).astype(np.float32)
    key_chunk = jnp.arange(s_len, dtype=jnp.int32) // CHUNK

    def block(args):
        qb, t0 = args
        sc = jnp.einsum('bhqd,bhkd->bhqk', qb, k).astype(jnp.float32) * scale
        q_chunk = (t0 + jnp.arange(Q_BLOCK, dtype=jnp.int32)) // CHUNK
        mask = key_chunk[None, :] <= q_chunk[:, None]
        p = jax.nn.softmax(jnp.where(mask, sc, -jnp.inf), axis=-1)
        return jnp.einsum('bhqk,bhkd->bhqd', p.astype(v.dtype), v)

    return sweep_query_blocks(block, q)


def hybrid_layer(x, mem, positions, g_mix, g_mem, w_in, g_cq, g_ckv, w_q_b, w_kv_b,
                 g_q_mla, g_k_mla, w_mem_kv, g_q_mem, g_k_mem, w_sb_o, w_mla_o, w_mem_o,
                 w_out, g_ffn, w_ff1, w_ff2):
    b, s, _ = x.shape
    h = rmsnorm(x, g_mix)
    proj = h @ w_in
    cuts, acc = [], 0
    for n in IN_SIZES[:-1]:
        acc += n
        cuts.append(acc)
    sb_q, sb_k, sb_v, c_q, c_kv, k_pe, mem_q, gate_logits = jnp.split(proj, cuts, axis=-1)

    o_sb = merge_heads(stick_breaking_attention(to_heads(sb_q, SB_HEADS),
                                                to_heads(sb_k, SB_HEADS),
                                                to_heads(sb_v, SB_HEADS)))

    q = to_heads(rmsnorm(c_q, g_cq) @ w_q_b, MLA_HEADS)
    q = jnp.concatenate([q[..., :NOPE_DIM], rope(q[..., NOPE_DIM:], positions)], axis=-1)
    kv = to_heads(rmsnorm(c_kv, g_ckv) @ w_kv_b, MLA_HEADS)
    k_nope, v_mla = kv[..., :NOPE_DIM], kv[..., NOPE_DIM:]
    k_rot = jnp.broadcast_to(rope(k_pe, positions)[:, None], (b, MLA_HEADS, s, ROPE_DIM))
    k = jnp.concatenate([k_nope, k_rot], axis=-1)
    q, k = rmsnorm(q, g_q_mla), rmsnorm(k, g_k_mla)
    o_mla = merge_heads(chunk_causal_softmax_attention(q, k, v_mla))

    mkv = rmsnorm(mem, g_mem) @ w_mem_kv
    mk, mv = to_heads(mkv[..., :MEM_W], MEM_HEADS), to_heads(mkv[..., MEM_W:], MEM_HEADS)
    mq = rmsnorm(to_heads(mem_q, MEM_HEADS), g_q_mem)
    mk = rmsnorm(mk, g_k_mem)
    sc = jnp.einsum('bhqd,bhkd->bhqk', mq, mk).astype(jnp.float32) / np.float32(np.sqrt(MEM_HEAD_DIM))
    p = jax.nn.softmax(sc, axis=-1)
    o_mem = merge_heads(jnp.einsum('bhqk,bhkd->bhqd', p.astype(mv.dtype), mv))

    gates = jax.nn.sigmoid(gate_logits.astype(jnp.float32)).reshape(b, s, N_BRANCH, D_MODEL)
    merged = (gates[:, :, 0] * (o_sb @ w_sb_o).astype(jnp.float32)
              + gates[:, :, 1] * (o_mla @ w_mla_o).astype(jnp.float32)
              + gates[:, :, 2] * (o_mem @ w_mem_o).astype(jnp.float32)).astype(x.dtype)
    x = x + merged @ w_out

    u = jax.nn.relu(rmsnorm(x, g_ffn) @ w_ff1)
    return x + (u * u) @ w_ff2


def setup_inputs(seed: int = 0) -> dict:
    key = jax.random.key(seed)
    ks = jax.random.split(key, 24)
    f32 = jnp.float32

    def w(k, shape, fan_in):
        return jax.random.normal(k, (DEPTH,) + shape, f32) * (fan_in ** -0.5)

    def gain(k, n):
        return 1.0 + 0.05 * jax.random.normal(k, (DEPTH, n), f32)

    x = jax.random.normal(ks[0], (BATCH, SEQ, D_MODEL), f32)
    mem = jax.random.normal(ks[1], (BATCH, N_MEM, D_MODEL), f32)
    start = jax.random.randint(ks[2], (BATCH, 1), 0, 1024, dtype=jnp.int32)
    positions = start + jnp.arange(SEQ, dtype=jnp.int32)[None, :]
    return {
        "x": x,
        "mem": mem,
        "positions": positions,
        "g_mix": gain(ks[3], D_MODEL),
        "g_mem": gain(ks[4], D_MODEL),
        "w_in": w(ks[5], (D_MODEL, N_IN), D_MODEL),
        "g_cq": gain(ks[6], Q_LORA),
        "g_ckv": gain(ks[7], KV_LORA),
        "w_q_b": w(ks[8], (Q_LORA, MLA_HEADS * QK_DIM), Q_LORA),
        "w_kv_b": w(ks[9], (KV_LORA, MLA_HEADS * (NOPE_DIM + V_DIM)), KV_LORA),
        "g_q_mla": gain(ks[10], QK_DIM),
        "g_k_mla": gain(ks[11], QK_DIM),
        "w_mem_kv": w(ks[12], (D_MODEL, 2 * MEM_W), D_MODEL),
        "g_q_mem": gain(ks[13], MEM_HEAD_DIM),
        "g_k_mem": gain(ks[14], MEM_HEAD_DIM),
        "w_sb_o": w(ks[15], (SB_W, D_MODEL), SB_W),
        "w_mla_o": w(ks[16], (MLA_W, D_MODEL), MLA_W),
        "w_mem_o": w(ks[17], (MEM_W, D_MODEL), MEM_W),
        "w_out": w(ks[18], (D_MODEL, D_MODEL), D_MODEL),
        "g_ffn": gain(ks[19], D_MODEL),
        "w_ff1": w(ks[20], (D_MODEL, D_FF), D_MODEL),
        "w_ff2": w(ks[21], (D_FF, D_MODEL), D_FF),
    }


def reference(x, mem, positions, g_mix, g_mem, w_in, g_cq, g_ckv, w_q_b, w_kv_b,
              g_q_mla, g_k_mla, w_mem_kv, g_q_mem, g_k_mem, w_sb_o, w_mla_o, w_mem_o,
              w_out, g_ffn, w_ff1, w_ff2):
    for i in range(DEPTH):
        x = hybrid_layer(x, mem, positions, g_mix[i], g_mem[i], w_in[i], g_cq[i], g_ckv[i],
                         w_q_b[i], w_kv_b[i], g_q_mla[i], g_k_mla[i], w_mem_kv[i],
                         g_q_mem[i], g_k_mem[i], w_sb_o[i], w_mla_o[i], w_mem_o[i],
                         w_out[i], g_ffn[i], w_ff1[i], w_ff2[i])
    return x
```

```cpp
#include <hip/hip_runtime.h>
#include <cstdio>
#include <cstdint>
namespace pg8 {
#define PG8_LAS __attribute__((address_space(3)))
typedef unsigned short bf16_t;
typedef short bf16x8 __attribute__((ext_vector_type(8)));
typedef float f32x4 __attribute__((ext_vector_type(4)));
typedef unsigned u32x4 __attribute__((ext_vector_type(4)));
constexpr int BM = 256, BK = 64, HALF = 128, HTB = HALF * BK * 2  , STAGE_BYTES = 8 * HTB, NXCD = 8, WGM = 8;

__host__ __device__ __forceinline__ int lds_byte(int r, int c) { const int st = (r >> 4) * 2 + (c >> 5), rr = r & 15, cc = c & 31, ob = rr * 64 + cc * 2; return st * 1024 + (ob ^ (((ob >> 9) & 1) << 5)); }
__host__ __device__ __forceinline__ void stage_rc(int b, int& R, int& C) { const int st = b / 1024, sb = b % 1024, swz = sb ^ (((sb >> 9) & 1) << 5); R = (st >> 1) * 16 + swz / 64; C = (st & 1) * 32 + (swz % 64) / 2; }
__host__ __device__ __forceinline__ int perm32(int rho) { const int n = rho >> 4, i = rho & 15; return 8 * (i >> 2) + 4 * n + (i & 3); }

struct Unit { int pm, pn; };
struct Gemm { const bf16_t* A; const bf16_t* Bt; int M, N, K; int lda = 0, ldb = 0; };

struct StaticOrder {
    int nM, nN, nwg, G, c, wgm;
    __host__ __device__ void init(int M, int N, int G_, int c_, int wgm_ = WGM) { nM = M / BM; nN = N / BM; nwg = nM * nN; G = G_; c = c_; wgm = wgm_; }
    __host__ __device__ bool next(int i, Unit& u) const {
        const long L = (long)i * G + c; if (L >= nwg) return false;
        int wgid = (int)L; { const int q = nwg / NXCD, r = nwg % NXCD, xcd = wgid % NXCD, off = wgid / NXCD; wgid = (xcd < r ? xcd * (q + 1) : r * (q + 1) + (xcd - r) * q) + off; }
        const int nig = wgm * nN, gid = wgid / nig, fm = gid * wgm, gsz = (nM - fm) < wgm ? (nM - fm) : wgm;
        u.pm = fm + ((wgid % nig) % gsz); u.pn = (wgid % nig) / gsz; return true;
    }
    __device__ __forceinline__ void a_ready(const Unit&) const {}
    __device__ __forceinline__ void done(const Unit&) const {}
};

__device__ __forceinline__ unsigned cvt_pk_bf16(float lo, float hi) { unsigned r; asm volatile("v_cvt_pk_bf16_f32 %0, %1, %2" : "=v"(r) : "v"(lo), "v"(hi)); return r; }
__device__ __forceinline__ float bflo(unsigned w) { return __builtin_bit_cast(float, w << 16); }
__device__ __forceinline__ float bfhi(unsigned w) { return __builtin_bit_cast(float, w & 0xffff0000u); }
__device__ __forceinline__ float sigm(float v) { return __builtin_amdgcn_rcpf(1.0f + __builtin_amdgcn_exp2f(v * -1.44269504089f)); }

struct EpiProj {
    static constexpr bool PERM = true, AFTER_DRAIN = false; static constexpr int NSEG = 1, SEG1 = -1, SEG2 = -1;
    bf16_t* O; int ldc; int sig_pn;
    float* ssq_a; float* ssq_b; int ha0, ha1, hb0, hb1;
    __device__ __forceinline__ void operator()(const f32x4 (&acc)[2][2][4][2], const Unit& u, int wr, int wc, int fr, int fq) const {
        const int row0 = u.pm * BM + wr * 64 + fr, col0 = u.pn * BM + wc * 32 + 8 * fq;
        const bool sg = u.pn >= sig_pn;
        const bool st = ssq_a != nullptr && 2 * u.pn + 1 >= ha0 && 2 * u.pn < hb1;
#pragma unroll
        for (int ai = 0; ai < 2; ++ai)
#pragma unroll
            for (int m = 0; m < 4; ++m) { const int row = row0 + ai * HALF + m * 16; bf16_t* rowp = O + (size_t)row * ldc + col0;
#pragma unroll
                for (int bj = 0; bj < 2; ++bj) { f32x4 v0 = acc[ai][bj][m][0], v1 = acc[ai][bj][m][1];
                    if (sg) {
#pragma unroll
                        for (int j = 0; j < 4; ++j) { v0[j] = sigm(v0[j]); v1[j] = sigm(v1[j]); } }
                    if (st) { const int hi = 2 * u.pn + bj;
                        float ss = (v0[0] * v0[0] + v0[1] * v0[1]) + (v0[2] * v0[2] + v0[3] * v0[3]) + (v1[0] * v1[0] + v1[1] * v1[1]) + (v1[2] * v1[2] + v1[3] * v1[3]);
                        ss += __shfl_xor(ss, 16); ss += __shfl_xor(ss, 32);
                        if (fq == 0) { if (hi >= ha0 && hi < ha1) atomicAdd(ssq_a + row, ss); else if (hi >= hb0 && hi < hb1) atomicAdd(ssq_b + row, ss); } }
                    u32x4 w; w.x = cvt_pk_bf16(v0[0], v0[1]); w.y = cvt_pk_bf16(v0[2], v0[3]); w.z = cvt_pk_bf16(v1[0], v1[1]); w.w = cvt_pk_bf16(v1[2], v1[3]);
                    *(u32x4*)(rowp + bj * HALF) = w; } }
    }
};

struct EpiRowScale {
    static constexpr bool PERM = true, AFTER_DRAIN = false; static constexpr int NSEG = 1, SEG1 = -1, SEG2 = -1;
    bf16_t* O; int ldc; const float* ssq; float inv_n, eps;
    __device__ __forceinline__ void operator()(const f32x4 (&acc)[2][2][4][2], const Unit& u, int wr, int wc, int fr, int fq) const {
        const int row0 = u.pm * BM + wr * 64 + fr, col0 = u.pn * BM + wc * 32 + 8 * fq;
        float sq[2][4];
#pragma unroll
        for (int ai = 0; ai < 2; ++ai)
#pragma unroll
            for (int m = 0; m < 4; ++m) sq[ai][m] = ssq[row0 + ai * HALF + m * 16];
        __builtin_amdgcn_sched_barrier(0);
#pragma unroll
        for (int ai = 0; ai < 2; ++ai)
#pragma unroll
            for (int m = 0; m < 4; ++m) { const size_t row = (size_t)(row0 + ai * HALF + m * 16);
                const float rs = 1.0f / __builtin_sqrtf(sq[ai][m] * inv_n + eps);
                bf16_t* rowp = O + row * ldc + col0;
#pragma unroll
                for (int bj = 0; bj < 2; ++bj) { const f32x4 v0 = acc[ai][bj][m][0] * rs, v1 = acc[ai][bj][m][1] * rs;
                    u32x4 w; w.x = cvt_pk_bf16(v0[0], v0[1]); w.y = cvt_pk_bf16(v0[2], v0[3]); w.z = cvt_pk_bf16(v1[0], v1[1]); w.w = cvt_pk_bf16(v1[2], v1[3]);
                    *(u32x4*)(rowp + bj * HALF) = w; } }
    }
};

template <int MODE> struct EpiMerge {
    static constexpr bool PERM = true, AFTER_DRAIN = false; static constexpr int NSEG = 1, SEG1 = -1, SEG2 = -1;
    const bf16_t* G; int ldg; float* P; bf16_t* O; int ldp;
    __device__ __forceinline__ void operator()(const f32x4 (&acc)[2][2][4][2], const Unit& u, int wr, int wc, int fr, int fq) const {
        const int row0 = u.pm * BM + wr * 64 + fr, col0 = u.pn * BM + wc * 32 + 8 * fq;
#pragma unroll
        for (int ai = 0; ai < 2; ++ai)
#pragma unroll
            for (int m = 0; m < 4; ++m) { const size_t row = (size_t)(row0 + ai * HALF + m * 16);
#pragma unroll
                for (int bj = 0; bj < 2; ++bj) { const int col = col0 + bj * HALF;
                    const u32x4 g = *(const u32x4*)(G + row * ldg + col);
                    f32x4 v0 = acc[ai][bj][m][0], v1 = acc[ai][bj][m][1];
                    v0[0] *= bflo(g.x); v0[1] *= bfhi(g.x); v0[2] *= bflo(g.y); v0[3] *= bfhi(g.y);
                    v1[0] *= bflo(g.z); v1[1] *= bfhi(g.z); v1[2] *= bflo(g.w); v1[3] *= bfhi(g.w);
                    float* pp = P + row * ldp + col;
                    if (MODE > 0) { v0 += *(const f32x4*)pp; v1 += *(const f32x4*)(pp + 4); }
                    if (MODE < 2) { *(f32x4*)pp = v0; *(f32x4*)(pp + 4) = v1; }
                    else { u32x4 w; w.x = cvt_pk_bf16(v0[0], v0[1]); w.y = cvt_pk_bf16(v0[2], v0[3]); w.z = cvt_pk_bf16(v1[0], v1[1]); w.w = cvt_pk_bf16(v1[2], v1[3]);
                        *(u32x4*)(O + row * ldp + col) = w; } } }
    }
};

struct EpiMergeSeg {
    static constexpr bool PERM = true, AFTER_DRAIN = false; static constexpr int NSEG = 3, SEG1 = 24, SEG2 = 48;
    const bf16_t* G; int ldg; int gstride; bf16_t* O; int ldo;
    __device__ __forceinline__ void mid(f32x4 (&acc)[2][2][4][2], const Unit& u, int t, int wr, int wc, int fr, int fq) const {
        asm volatile("" : "+v"(fr), "+v"(fq));
        const int row0 = u.pm * BM + wr * 64 + fr, col0 = u.pn * BM + wc * 32 + 8 * fq;
        const bf16_t* gp = G + (t == SEG1 ? 0 : gstride); const bf16_t* gn = gp + gstride;
#pragma unroll
        for (int ai = 0; ai < 2; ++ai)
#pragma unroll
            for (int mh = 0; mh < 2; ++mh) { u32x4 ga[2][2], gb[2][2];
#pragma unroll
                for (int mm = 0; mm < 2; ++mm)
#pragma unroll
                    for (int bj = 0; bj < 2; ++bj) { const size_t o = (size_t)(row0 + ai * HALF + (2 * mh + mm) * 16) * ldg + col0 + bj * HALF; ga[mm][bj] = *(const u32x4*)(gp + o); gb[mm][bj] = *(const u32x4*)(gn + o); }
                __builtin_amdgcn_sched_barrier(0);
#pragma unroll
                for (int mm = 0; mm < 2; ++mm)
#pragma unroll
                    for (int bj = 0; bj < 2; ++bj) { const int m = 2 * mh + mm; const u32x4 a = ga[mm][bj], b = gb[mm][bj];
                        float pa[8] = {bflo(a.x), bfhi(a.x), bflo(a.y), bfhi(a.y), bflo(a.z), bfhi(a.z), bflo(a.w), bfhi(a.w)};
                        float pb[8] = {bflo(b.x), bfhi(b.x), bflo(b.y), bfhi(b.y), bflo(b.z), bfhi(b.z), bflo(b.w), bfhi(b.w)};
#pragma unroll
                        for (int j = 0; j < 8; ++j) { const float r = __builtin_fmaxf(pa[j], 1e-20f) * __builtin_amdgcn_rcpf(__builtin_fmaxf(pb[j], 1e-20f));
                            if (j < 4) acc[ai][bj][m][0][j] *= r; else acc[ai][bj][m][1][j - 4] *= r; } }
                __builtin_amdgcn_sched_barrier(0); }
    }
    __device__ __forceinline__ void operator()(const f32x4 (&acc)[2][2][4][2], const Unit& u, int wr, int wc, int fr, int fq) const {
        asm volatile("" : "+v"(fr), "+v"(fq));
        const int row0 = u.pm * BM + wr * 64 + fr, col0 = u.pn * BM + wc * 32 + 8 * fq;
        const bf16_t* g2 = G + 2 * gstride;
#pragma unroll
        for (int ai = 0; ai < 2; ++ai)
#pragma unroll
            for (int mh = 0; mh < 2; ++mh) { u32x4 gg[2][2];
#pragma unroll
                for (int mm = 0; mm < 2; ++mm)
#pragma unroll
                    for (int bj = 0; bj < 2; ++bj) gg[mm][bj] = *(const u32x4*)(g2 + (size_t)(row0 + ai * HALF + (2 * mh + mm) * 16) * ldg + col0 + bj * HALF);
                __builtin_amdgcn_sched_barrier(0);
#pragma unroll
                for (int mm = 0; mm < 2; ++mm)
#pragma unroll
                    for (int bj = 0; bj < 2; ++bj) { const int m = 2 * mh + mm; const u32x4 g = gg[mm][bj];
                        f32x4 v0 = acc[ai][bj][m][0], v1 = acc[ai][bj][m][1];
                        v0[0] *= __builtin_fmaxf(bflo(g.x), 1e-20f); v0[1] *= __builtin_fmaxf(bfhi(g.x), 1e-20f); v0[2] *= __builtin_fmaxf(bflo(g.y), 1e-20f); v0[3] *= __builtin_fmaxf(bfhi(g.y), 1e-20f);
                        v1[0] *= __builtin_fmaxf(bflo(g.z), 1e-20f); v1[1] *= __builtin_fmaxf(bfhi(g.z), 1e-20f); v1[2] *= __builtin_fmaxf(bflo(g.w), 1e-20f); v1[3] *= __builtin_fmaxf(bfhi(g.w), 1e-20f);
                        u32x4 w; w.x = cvt_pk_bf16(v0[0], v0[1]); w.y = cvt_pk_bf16(v0[2], v0[3]); w.z = cvt_pk_bf16(v1[0], v1[1]); w.w = cvt_pk_bf16(v1[2], v1[3]);
                        *(u32x4*)(O + (size_t)(row0 + ai * HALF + m * 16) * ldo + col0 + bj * HALF) = w; }
                __builtin_amdgcn_sched_barrier(0); }
    }
};

struct EpiWout {
    static constexpr bool PERM = true, AFTER_DRAIN = false; static constexpr int NSEG = 1, SEG1 = -1, SEG2 = -1;
    const float* X; bf16_t* X1B; bf16_t* XG; const float* gf; float* ssq; int ld;
    __device__ __forceinline__ void operator()(const f32x4 (&acc)[2][2][4][2], const Unit& u, int wr, int wc, int fr, int fq) const {
        const int row0 = u.pm * BM + wr * 64 + fr, col0 = u.pn * BM + wc * 32 + 8 * fq;
        f32x4 gv[2][2];
#pragma unroll
        for (int bj = 0; bj < 2; ++bj)
#pragma unroll
            for (int n = 0; n < 2; ++n) gv[bj][n] = *(const f32x4*)(gf + col0 + bj * HALF + 4 * n);
#pragma unroll
        for (int ai = 0; ai < 2; ++ai)
#pragma unroll
            for (int mh = 0; mh < 2; ++mh) { f32x4 xa[2][2][2];
#pragma unroll
                for (int mm = 0; mm < 2; ++mm)
#pragma unroll
                    for (int bj = 0; bj < 2; ++bj) { const size_t o = (size_t)(row0 + ai * HALF + (2 * mh + mm) * 16) * ld + col0 + bj * HALF; xa[mm][bj][0] = *(const f32x4*)(X + o); xa[mm][bj][1] = *(const f32x4*)(X + o + 4); }
                __builtin_amdgcn_sched_barrier(0);
#pragma unroll
                for (int mm = 0; mm < 2; ++mm) { const int m = 2 * mh + mm; const size_t row = (size_t)(row0 + ai * HALF + m * 16); float ss = 0.f;
#pragma unroll
                    for (int bj = 0; bj < 2; ++bj) { const size_t o = row * ld + col0 + bj * HALF;
                        const f32x4 v0 = acc[ai][bj][m][0] + xa[mm][bj][0], v1 = acc[ai][bj][m][1] + xa[mm][bj][1];
                        u32x4 xw; xw.x = cvt_pk_bf16(v0[0], v0[1]); xw.y = cvt_pk_bf16(v0[2], v0[3]); xw.z = cvt_pk_bf16(v1[0], v1[1]); xw.w = cvt_pk_bf16(v1[2], v1[3]);
                        *(u32x4*)(X1B + o) = xw;
                        ss += (v0[0] * v0[0] + v0[1] * v0[1]) + (v0[2] * v0[2] + v0[3] * v0[3]) + (v1[0] * v1[0] + v1[1] * v1[1]) + (v1[2] * v1[2] + v1[3] * v1[3]);
                        const f32x4 a = v0 * gv[bj][0], b = v1 * gv[bj][1];
                        u32x4 w; w.x = cvt_pk_bf16(a[0], a[1]); w.y = cvt_pk_bf16(a[2], a[3]); w.z = cvt_pk_bf16(b[0], b[1]); w.w = cvt_pk_bf16(b[2], b[3]);
                        *(u32x4*)(XG + o) = w; }
                    ss += __shfl_xor(ss, 16); ss += __shfl_xor(ss, 32);
                    if (fq == 0) atomicAdd(ssq + row, ss); }
                __builtin_amdgcn_sched_barrier(0); }
    }
};

struct EpiFF1 {
    static constexpr bool PERM = true, AFTER_DRAIN = false; static constexpr int NSEG = 1, SEG1 = -1, SEG2 = -1;
    bf16_t* U; int ldc; const float* ssq; float inv_n, eps;
    __device__ __forceinline__ void operator()(const f32x4 (&acc)[2][2][4][2], const Unit& u, int wr, int wc, int fr, int fq) const {
        const int row0 = u.pm * BM + wr * 64 + fr, col0 = u.pn * BM + wc * 32 + 8 * fq;
        float sq[2][4];
#pragma unroll
        for (int ai = 0; ai < 2; ++ai)
#pragma unroll
            for (int m = 0; m < 4; ++m) sq[ai][m] = ssq[row0 + ai * HALF + m * 16];
        __builtin_amdgcn_sched_barrier(0);
#pragma unroll
        for (int ai = 0; ai < 2; ++ai)
#pragma unroll
            for (int m = 0; m < 4; ++m) { const size_t row = (size_t)(row0 + ai * HALF + m * 16);
                const float rs = 1.0f / __builtin_sqrtf(sq[ai][m] * inv_n + eps);
                bf16_t* rowp = U + row * ldc + col0;
#pragma unroll
                for (int bj = 0; bj < 2; ++bj) { f32x4 v0 = acc[ai][bj][m][0] * rs, v1 = acc[ai][bj][m][1] * rs;
#pragma unroll
                    for (int j = 0; j < 4; ++j) { const float a = __builtin_fmaxf(v0[j], 0.f), b = __builtin_fmaxf(v1[j], 0.f); v0[j] = a * a; v1[j] = b * b; }
                    u32x4 w; w.x = cvt_pk_bf16(v0[0], v0[1]); w.y = cvt_pk_bf16(v0[2], v0[3]); w.z = cvt_pk_bf16(v1[0], v1[1]); w.w = cvt_pk_bf16(v1[2], v1[3]);
                    *(u32x4*)(rowp + bj * HALF) = w; } }
    }
};

struct EpiAccF32 {
    static constexpr bool PERM = true, AFTER_DRAIN = false; static constexpr int NSEG = 1, SEG1 = -1, SEG2 = -1;
    float* C; const bf16_t* X1B; int ldc;
    __device__ __forceinline__ void operator()(const f32x4 (&acc)[2][2][4][2], const Unit& u, int wr, int wc, int fr, int fq) const {
        const int row0 = u.pm * BM + wr * 64 + fr, col0 = u.pn * BM + wc * 32 + 8 * fq;
#pragma unroll
        for (int ai = 0; ai < 2; ++ai) { u32x4 xw[4][2];
#pragma unroll
            for (int m = 0; m < 4; ++m)
#pragma unroll
                for (int bj = 0; bj < 2; ++bj) xw[m][bj] = *(const u32x4*)(X1B + (size_t)(row0 + ai * HALF + m * 16) * ldc + col0 + bj * HALF);
            __builtin_amdgcn_sched_barrier(0);
#pragma unroll
            for (int m = 0; m < 4; ++m) { const size_t ro = (size_t)(row0 + ai * HALF + m * 16) * ldc + col0;
#pragma unroll
                for (int bj = 0; bj < 2; ++bj) { const u32x4 x = xw[m][bj];
                    f32x4 v0 = acc[ai][bj][m][0], v1 = acc[ai][bj][m][1];
                    v0[0] += bflo(x.x); v0[1] += bfhi(x.x); v0[2] += bflo(x.y); v0[3] += bfhi(x.y); v1[0] += bflo(x.z); v1[1] += bfhi(x.z); v1[2] += bflo(x.w); v1[3] += bfhi(x.w);
                    float* p = C + ro + bj * HALF; *(f32x4*)p = v0; *(f32x4*)(p + 4) = v1; } }
            __builtin_amdgcn_sched_barrier(0); }
    }
};

template <class Epi, class Sched, bool ALIGN_EPI = false, bool SP2 = false>
__device__ __forceinline__ void gemm_phase(PG8_LAS unsigned char* lds, const Gemm g, const Sched& S, const Epi& E) {
    const int tid = threadIdx.x, wid = __builtin_amdgcn_readfirstlane(tid >> 6), lane = tid & 63, wr = wid >> 2, wc = wid & 3, fr = lane & 15, fq = lane >> 4;
    const int K = g.K, nt = K / BK, lda = g.lda ? g.lda : K, ldb = g.ldb ? g.ldb : K;
    unsigned voffA[2], voffB[2];
#pragma unroll
    for (int i = 0; i < 2; ++i) { int R, C; stage_rc(tid * 16 + i * 8192, R, C); const int Rb = Epi::PERM ? ((R & ~31) + perm32(R & 31)) : R;
        voffA[i] = (unsigned)(R * lda + C) * 2u; voffB[i] = (unsigned)(Rb * ldb + C) * 2u; }
    const size_t kstep = (size_t)(BK * 2);
    const size_t hstepA = (size_t)HALF * lda * 2, hstepB = (size_t)HALF * ldb * 2;
    const size_t tstepA = 2 * hstepA, tstepB = 2 * hstepB;
    const unsigned ldsw = (unsigned)wid * 1024u;
    const int aoff = lds_byte(wr * 64 + fr, fq * 8), boff = lds_byte(wc * 32 + fr, fq * 8);
#define PG8_SA(b, h) (((b) * 2 + (h)) * HTB)
#define PG8_SB(b, h) ((4 + (b) * 2 + (h)) * HTB)
#define PG8_STAGE(bufoff, gbase, voff) do { _Pragma("unroll") for (int _i = 0; _i < 2; ++_i) \
        __builtin_amdgcn_global_load_lds((const unsigned*)((const char*)(gbase) + (voff)[_i]), (PG8_LAS unsigned*)(lds + (bufoff) + ldsw + _i * 8192), 16, 0, 0); } while (0)
#define PG8_LDA(dst, b, h) do { _Pragma("unroll") for (int m = 0; m < 4; ++m) _Pragma("unroll") for (int k = 0; k < 2; ++k) dst[m][k] = *(const PG8_LAS bf16x8*)(lds + PG8_SA(b, h) + aoff + m * 2048 + k * 1024); } while (0)
#define PG8_LDB(dst, b, h) do { _Pragma("unroll") for (int n = 0; n < 2; ++n) _Pragma("unroll") for (int k = 0; k < 2; ++k) dst[n][k] = *(const PG8_LAS bf16x8*)(lds + PG8_SB(b, h) + boff + n * 2048 + k * 1024); } while (0)
#define PG8_MMA(ai, bj, At, Bt) do { __builtin_amdgcn_s_setprio(1); _Pragma("unroll") for (int m = 0; m < 4; ++m) _Pragma("unroll") for (int n = 0; n < 2; ++n) _Pragma("unroll") for (int k = 0; k < 2; ++k) \
        acc[ai][bj][m][n] = __builtin_amdgcn_mfma_f32_16x16x32_bf16(Bt[n][k], At[m][k], acc[ai][bj][m][n], 0, 0, 0); __builtin_amdgcn_s_setprio(0); } while (0)
#define PG8_WAIT_V(n) asm volatile("s_waitcnt vmcnt(" #n ")" ::: "memory")
#define PG8_WAIT_L(n) asm volatile("s_waitcnt lgkmcnt(" #n ")" ::: "memory")
#define PG8_BAR __builtin_amdgcn_s_barrier()
#define PG8_SCHED __builtin_amdgcn_sched_barrier(0)
    Unit cur, nxt; int ui = 0;
    if (!S.next(0, cur)) return;
    f32x4 acc[2][2][4][2];
#pragma unroll
    for (int a = 0; a < 2; ++a)
#pragma unroll
        for (int b = 0; b < 2; ++b)
#pragma unroll
            for (int m = 0; m < 4; ++m)
#pragma unroll
                for (int n = 0; n < 2; ++n) acc[a][b][m][n] = (f32x4){0.f, 0.f, 0.f, 0.f};
    bf16x8 At[4][2], B0[2][2], B1[2][2];
    const char* cA = (const char*)g.A + (size_t)cur.pm * tstepA; const char* cB = (const char*)g.Bt + (size_t)cur.pn * tstepB;
    S.a_ready(cur);
    if constexpr (SP2) {
        PG8_STAGE(PG8_SB(0, 0), cB, voffB); PG8_STAGE(PG8_SB(0, 1), cB + hstepB, voffB); PG8_STAGE(PG8_SA(0, 0), cA, voffA); PG8_STAGE(PG8_SA(0, 1), cA + hstepA, voffA);
        if (wr == 1) PG8_BAR;
        PG8_WAIT_V(2); PG8_BAR;
        PG8_STAGE(PG8_SB(1, 0), cB + kstep, voffB); PG8_STAGE(PG8_SA(1, 0), cA + kstep, voffA); PG8_STAGE(PG8_SB(1, 1), cB + hstepB + kstep, voffB);
        PG8_WAIT_V(6); PG8_BAR;
    } else {
        PG8_STAGE(PG8_SB(0, 0), cB, voffB); PG8_STAGE(PG8_SA(0, 0), cA, voffA); PG8_STAGE(PG8_SB(0, 1), cB + hstepB, voffB); PG8_STAGE(PG8_SA(0, 1), cA + hstepA, voffA);
        if (wr == 1) PG8_BAR;
        PG8_WAIT_V(4); PG8_BAR;
        PG8_STAGE(PG8_SB(1, 0), cB + kstep, voffB); PG8_STAGE(PG8_SA(1, 0), cA + kstep, voffA); PG8_STAGE(PG8_SB(1, 1), cB + hstepB + kstep, voffB);
        PG8_WAIT_V(6); PG8_BAR;
    }
    for (;;) {
        const bool has_next = S.next(ui + 1, nxt);
        const char* nA = has_next ? (const char*)g.A + (size_t)nxt.pm * tstepA : cA; const char* nB = has_next ? (const char*)g.Bt + (size_t)nxt.pn * tstepB : cB;
        int tb_ = 0;
#pragma nounroll
        for (int seg_ = 0; seg_ < Epi::NSEG; ++seg_) {
        const int te_ = (Epi::NSEG == 1) ? nt : (seg_ == 0 ? Epi::SEG1 : (seg_ == 1 ? Epi::SEG2 : nt));
        for (int t = tb_; t < te_; t += 2) {
            const bool last = (t == nt - 2);
            const char* a1 = cA + (size_t)(t + 1) * kstep;
            const char* a2 = last ? nA : cA + (size_t)(t + 2) * kstep; const char* b2 = last ? nB : cB + (size_t)(t + 2) * kstep;
            const char* a3 = a2 + kstep; const char* b3 = b2 + kstep;
            if (last && has_next) S.a_ready(nxt);
            if constexpr (SP2) {
            PG8_LDB(B0, 0, 0); PG8_LDB(B1, 0, 1); PG8_SCHED; PG8_LDA(At, 0, 0); PG8_STAGE(PG8_SA(1, 1), a1 + hstepA, voffA);
            PG8_WAIT_V(8); PG8_WAIT_L(0); PG8_BAR; PG8_MMA(0, 0, At, B0); PG8_MMA(0, 1, At, B1); PG8_BAR; PG8_SCHED;
            PG8_LDA(At, 0, 1); PG8_STAGE(PG8_SB(0, 0), b2, voffB); PG8_STAGE(PG8_SB(0, 1), b2 + hstepB, voffB); PG8_STAGE(PG8_SA(0, 0), a2, voffA);
            PG8_WAIT_V(8); PG8_WAIT_L(0); PG8_BAR; PG8_MMA(1, 0, At, B0); PG8_MMA(1, 1, At, B1); PG8_BAR; PG8_SCHED;
            PG8_LDB(B0, 1, 0); PG8_LDB(B1, 1, 1); PG8_SCHED; PG8_LDA(At, 1, 0); PG8_STAGE(PG8_SA(0, 1), a2 + hstepA, voffA);
            PG8_WAIT_V(8); PG8_WAIT_L(0); PG8_BAR; PG8_MMA(0, 0, At, B0); PG8_MMA(0, 1, At, B1); PG8_BAR; PG8_SCHED;
            PG8_LDA(At, 1, 1); PG8_STAGE(PG8_SB(1, 0), b3, voffB); PG8_STAGE(PG8_SB(1, 1), b3 + hstepB, voffB); PG8_STAGE(PG8_SA(1, 0), a3, voffA);
            PG8_WAIT_V(8); PG8_WAIT_L(0); PG8_BAR; PG8_MMA(1, 0, At, B0); PG8_MMA(1, 1, At, B1); PG8_BAR; PG8_SCHED;
            } else {
            PG8_LDB(B0, 0, 0); PG8_SCHED; PG8_LDA(At, 0, 0); PG8_STAGE(PG8_SA(1, 1), a1 + hstepA, voffA);
            PG8_WAIT_L(8); PG8_BAR; PG8_WAIT_L(0); PG8_MMA(0, 0, At, B0); PG8_BAR; PG8_SCHED;
            PG8_LDB(B1, 0, 1); PG8_STAGE(PG8_SB(0, 0), b2, voffB);
            PG8_BAR; PG8_WAIT_L(0); PG8_MMA(0, 1, At, B1); PG8_BAR;
            PG8_LDA(At, 0, 1); PG8_STAGE(PG8_SA(0, 0), a2, voffA);
            PG8_BAR; PG8_WAIT_L(0); PG8_MMA(1, 0, At, B0); PG8_BAR; PG8_SCHED;
            PG8_STAGE(PG8_SB(0, 1), b2 + hstepB, voffB);
            PG8_WAIT_V(6); PG8_BAR; PG8_MMA(1, 1, At, B1); PG8_BAR;
            PG8_LDB(B0, 1, 0); PG8_SCHED; PG8_LDA(At, 1, 0); PG8_STAGE(PG8_SA(0, 1), a2 + hstepA, voffA);
            PG8_WAIT_L(8); PG8_BAR; PG8_WAIT_L(0); PG8_MMA(0, 0, At, B0); PG8_BAR; PG8_SCHED;
            PG8_LDB(B1, 1, 1); PG8_STAGE(PG8_SB(1, 0), b3, voffB);
            PG8_BAR; PG8_WAIT_L(0); PG8_MMA(0, 1, At, B1); PG8_BAR;
            PG8_LDA(At, 1, 1); PG8_STAGE(PG8_SA(1, 0), a3, voffA);
            PG8_BAR; PG8_WAIT_L(0); PG8_MMA(1, 0, At, B0); PG8_BAR; PG8_SCHED;
            PG8_STAGE(PG8_SB(1, 1), b3 + hstepB, voffB);
            PG8_WAIT_V(6); PG8_BAR; PG8_MMA(1, 1, At, B1); PG8_BAR;
            }
        }
        if constexpr (Epi::NSEG > 1) { if (seg_ + 1 < Epi::NSEG) E.mid(acc, cur, te_, wr, wc, fr, fq); }
        tb_ = te_;
        }
        if constexpr (ALIGN_EPI) { if (wr == 0) PG8_BAR; }
        if constexpr (!Epi::AFTER_DRAIN) { E(acc, cur, wr, wc, fr, fq); S.done(cur); }
        if (!has_next) break;
#pragma unroll
        for (int a = 0; a < 2; ++a)
#pragma unroll
            for (int b = 0; b < 2; ++b)
#pragma unroll
                for (int m = 0; m < 4; ++m)
#pragma unroll
                    for (int n = 0; n < 2; ++n) acc[a][b][m][n] = (f32x4){0.f, 0.f, 0.f, 0.f};
        cur = nxt; cA = nA; cB = nB; ++ui;
        if constexpr (ALIGN_EPI) { if (wr == 1) PG8_BAR; }
    }
    PG8_WAIT_V(0);
    if constexpr (!ALIGN_EPI) { if (wr == 0) PG8_BAR; }
    PG8_BAR;
    if constexpr (Epi::AFTER_DRAIN) { E.fused(acc, cur, wr, wc, fr, fq, lds, wid, lane); S.done(cur); }
#undef PG8_SA
#undef PG8_SB
#undef PG8_STAGE
#undef PG8_LDA
#undef PG8_LDB
#undef PG8_MMA
#undef PG8_WAIT_V
#undef PG8_WAIT_L
#undef PG8_BAR
#undef PG8_SCHED
}
}

namespace att {
typedef short bf16x8 __attribute__((ext_vector_type(8)));
typedef short s16x4 __attribute__((ext_vector_type(4)));
typedef float f32x16 __attribute__((ext_vector_type(16)));
typedef unsigned u32x4 __attribute__((ext_vector_type(4)));
typedef unsigned u32x2 __attribute__((ext_vector_type(2)));
typedef float f32x4 __attribute__((ext_vector_type(4)));
#define ATT_LAS __attribute__((address_space(3)))
constexpr int KBUF = 32768, VBUF = 16384, STAGE = KBUF + VBUF;

__device__ __forceinline__ bf16x8 pack_step(const f32x16& x, int s) {
    u32x4 p;
    asm volatile("v_cvt_pk_bf16_f32 %0, %4, %5\n\tv_cvt_pk_bf16_f32 %1, %6, %7\n\tv_cvt_pk_bf16_f32 %2, %8, %9\n\tv_cvt_pk_bf16_f32 %3, %10, %11\n\ts_nop 1"
                 : "=&v"(p[0]), "=&v"(p[1]), "=&v"(p[2]), "=&v"(p[3])
                 : "v"(x[8 * s]), "v"(x[8 * s + 1]), "v"(x[8 * s + 2]), "v"(x[8 * s + 3]), "v"(x[8 * s + 4]), "v"(x[8 * s + 5]), "v"(x[8 * s + 6]), "v"(x[8 * s + 7]));
    return __builtin_bit_cast(bf16x8, p);
}
template <int OFF> __device__ __forceinline__ s16x4 tr_read(unsigned addr) {
    s16x4 r; asm volatile("ds_read_b64_tr_b16 %0, %1 offset:%2" : "=&v"(r) : "v"(addr), "i"(OFF) : "memory"); return r;
}
#define ATT_MFMA(a, b, c) __builtin_amdgcn_mfma_f32_32x32x16_bf16((a), (b), (c), 0, 0, 0)

template <int NKS, bool ROPE>
__device__ __forceinline__ void load_q_norm(bf16x8 (&qf)[NKS], const unsigned short* qrow, int h, const float* rc_row, const float* gain, float inv_n, float eps, float qscale = 1.0f) {
    float qv[NKS][8];
#pragma unroll
    for (int ks = 0; ks < NKS; ++ks) { const u32x4 w = *(const u32x4*)(qrow + 16 * ks + 8 * h);
        qv[ks][0] = __builtin_bit_cast(float, w.x << 16); qv[ks][1] = __builtin_bit_cast(float, w.x & 0xffff0000u); qv[ks][2] = __builtin_bit_cast(float, w.y << 16); qv[ks][3] = __builtin_bit_cast(float, w.y & 0xffff0000u);
        qv[ks][4] = __builtin_bit_cast(float, w.z << 16); qv[ks][5] = __builtin_bit_cast(float, w.z & 0xffff0000u); qv[ks][6] = __builtin_bit_cast(float, w.w << 16); qv[ks][7] = __builtin_bit_cast(float, w.w & 0xffff0000u); }
    if (ROPE) {
#pragma unroll
        for (int kk = 0; kk < 2; ++kk) { const float* cp = rc_row + 16 * kk + 8 * h;
            const f32x4 c0 = *(const f32x4*)cp, c1 = *(const f32x4*)(cp + 4), s0 = *(const f32x4*)(cp + 32), s1 = *(const f32x4*)(cp + 36);
#pragma unroll
            for (int j = 0; j < 8; ++j) { const float c = j < 4 ? c0[j & 3] : c1[j & 3], sn = j < 4 ? s0[j & 3] : s1[j & 3];
                const float t1 = qv[8 + kk][j], t2 = qv[10 + kk][j]; qv[8 + kk][j] = t1 * c - t2 * sn; qv[10 + kk][j] = t2 * c + t1 * sn; } } }
    float ss = 0.f;
#pragma unroll
    for (int ks = 0; ks < NKS; ++ks)
#pragma unroll
        for (int j = 0; j < 8; ++j) ss += qv[ks][j] * qv[ks][j];
    ss += __shfl_xor(ss, 32);
    const float rstd = qscale / __builtin_sqrtf(ss * inv_n + eps);
#pragma unroll
    for (int ks = 0; ks < NKS; ++ks) { f32x4 g0 = (f32x4){1.f, 1.f, 1.f, 1.f}, g1 = g0;
        if (gain) { g0 = *(const f32x4*)(gain + 16 * ks + 8 * h); g1 = *(const f32x4*)(gain + 16 * ks + 8 * h + 4); }
        u32x4 p; p.x = pg8::cvt_pk_bf16(qv[ks][0] * rstd * g0[0], qv[ks][1] * rstd * g0[1]); p.y = pg8::cvt_pk_bf16(qv[ks][2] * rstd * g0[2], qv[ks][3] * rstd * g0[3]);
        p.z = pg8::cvt_pk_bf16(qv[ks][4] * rstd * g1[0], qv[ks][5] * rstd * g1[1]); p.w = pg8::cvt_pk_bf16(qv[ks][6] * rstd * g1[2], qv[ks][7] * rstd * g1[3]);
        qf[ks] = __builtin_bit_cast(bf16x8, p); }
}

__device__ __forceinline__ void sb_block(f32x16& s, float& R, int kb0, int tlim, int h, float c2) {
    float z[16], sp[16], G[4], PG[4];
#pragma unroll
    for (int g = 0; g < 4; ++g) {
#pragma unroll
        for (int i = 0; i < 4; ++i) { const int idx = 4 * g + i;
            z[idx] = __builtin_fminf(s[idx] * c2, 60.0f);
            const float spv = __builtin_amdgcn_logf(1.0f + __builtin_amdgcn_exp2f(z[idx]));
            sp[idx] = (kb0 + 8 * g + 4 * h + i < tlim) ? spv : 0.0f; }
        G[g] = (sp[4 * g] + sp[4 * g + 1]) + (sp[4 * g + 2] + sp[4 * g + 3]);
    }
#pragma unroll
    for (int g = 0; g < 4; ++g) PG[g] = __shfl_xor(G[g], 32);
    float run = R;
#pragma unroll
    for (int g = 3; g >= 0; --g) {
        float e = run + (h == 0 ? PG[g] : 0.0f);
#pragma unroll
        for (int i = 3; i >= 0; --i) { const int idx = 4 * g + i;
            const float a = __builtin_amdgcn_exp2f(z[idx] - sp[idx] - e);
            s[idx] = (kb0 + 8 * g + 4 * h + i < tlim) ? a : 0.0f;
            e += sp[idx]; }
        run += G[g] + PG[g];
    }
    R = run;
}

template <int MODE, int DQK, bool QN = false>
__device__ __forceinline__ void attn_unit(ATT_LAS unsigned char* lds, const unsigned short* Q, int ldq, const unsigned short* K, int ldk, const unsigned short* V, int ldv, unsigned short* O, int ldo,
                                          int q0, int jfirst, int jstep, int ntiles, int jd, float c2, float shift, volatile ATT_LAS unsigned* flags, int tid, int lane, int wave) {
    constexpr int NA = DQK / 128, NKS = DQK / 16, NKI = 64 * DQK / 8 / 512;
    const int r = lane & 31, h = lane >> 5;
    const int t = q0 + 32 * wave + r;
    bf16x8 qf[NKS];
    if (QN) load_q_norm<NKS, false>(qf, Q + (size_t)t * ldq, h, nullptr, nullptr, 1.0f / DQK, 1e-6f);
    else { const unsigned short* qp = Q + (size_t)t * ldq + 8 * h;
#pragma unroll
      for (int ks = 0; ks < NKS; ++ks) qf[ks] = *(const bf16x8*)(qp + 16 * ks); }
    f32x16 o[4];
#pragma unroll
    for (int d = 0; d < 4; ++d)
#pragma unroll
        for (int i = 0; i < 16; ++i) o[d][i] = 0.f;
    float R = 0.f;
    int koff[NKI], voff[2];
#pragma unroll
    for (int i = 0; i < NKI; ++i) { const int cidx = tid + 512 * i;
        if (512 * i < NA * 1024) { const int c = cidx & 1023, key = c >> 4, ch = (c & 15) ^ (key & 15); koff[i] = key * ldk + 128 * (cidx >> 10) + 8 * ch; }
        else { const int c = cidx - NA * 1024, rowp = c >> 4, c16 = (c & 15) ^ (rowp & 15); koff[i] = (2 * rowp + (c16 >> 3)) * ldk + 128 * NA + 8 * (c16 & 7); } }
#pragma unroll
    for (int i = 0; i < 2; ++i) { const int cidx = tid + 512 * i; voff[i] = (8 * (cidx >> 7) + ((cidx >> 2) & 7)) * ldv + 32 * ((cidx >> 5) & 3) + 8 * (cidx & 3); }
    const unsigned ldsw = (unsigned)wave * 1024u;
#define ATT_STAGE(j, b) do { const unsigned short* kt_ = K + (size_t)(j) * 64 * ldk; const unsigned short* vt_ = V + (size_t)(j) * 64 * ldv; \
        _Pragma("unroll") for (int i_ = 0; i_ < NKI; ++i_) __builtin_amdgcn_global_load_lds((const unsigned*)(kt_ + koff[i_]), (ATT_LAS unsigned*)(lds + (b) * STAGE + ldsw + i_ * 8192), 16, 0, 0); \
        _Pragma("unroll") for (int i_ = 0; i_ < 2; ++i_) __builtin_amdgcn_global_load_lds((const unsigned*)(vt_ + voff[i_]), (ATT_LAS unsigned*)(lds + (b) * STAGE + KBUF + ldsw + i_ * 8192), 16, 0, 0); } while (0)
    const int a_base = r * 256, x15 = r & 15, b_base = (r >> 1) * 256, b_x = (r >> 1) & 15, b_hi = (r & 1) * 8;
    const unsigned lds0 = (unsigned)(size_t)lds;
    const unsigned v_lane = lds0 + KBUF + (unsigned)((4 * h + ((lane & 15) >> 2)) * 64 + 32 * ((lane >> 4) & 1) + 8 * (lane & 3));

    ATT_STAGE(jfirst, 0);
    for (int it = 0; it < ntiles; ++it) {
        const int j = jfirst + it * jstep, b = it & 1;
        asm volatile("s_waitcnt vmcnt(0)" ::: "memory");
        __syncthreads();
        if (MODE == 0 && it > 0) {
            unsigned all = 1u;
#pragma unroll
            for (int w = 0; w < 8; ++w) all &= flags[((it - 1) & 1) * 8 + w];
            if (__builtin_amdgcn_readfirstlane(all)) break;
        }
        if (it + 1 < ntiles) ATT_STAGE(j + jstep, b ^ 1);
        if (j <= jd) {
            ATT_LAS unsigned char* kb_ = lds + b * STAGE;
            f32x16 s0, s1;
#pragma unroll
            for (int i = 0; i < 16; ++i) { s0[i] = 0.f; s1[i] = 0.f; }
#pragma unroll
            for (int ks = 0; ks < NKS; ++ks) {
                int off0;
                if (ks < 8 * NA) off0 = (ks >> 3) * 16384 + a_base + (((2 * (ks & 7) + h) ^ x15) << 4);
                else off0 = NA * 16384 + b_base + (((b_hi + 2 * (ks - 8 * NA) + h) ^ b_x) << 4);
                const int kbs = (ks < 8 * NA) ? 8192 : 4096;
                const bf16x8 k0 = *(const ATT_LAS bf16x8*)(kb_ + off0), k1 = *(const ATT_LAS bf16x8*)(kb_ + off0 + kbs);
                s0 = ATT_MFMA(k0, qf[ks], s0); s1 = ATT_MFMA(k1, qf[ks], s1);
            }
            if (MODE == 0) { const int tlim = t - 64 * j; sb_block(s1, R, 32, tlim, h, c2); sb_block(s0, R, 0, tlim, h, c2); }
            else {
#pragma unroll
                for (int i = 0; i < 16; ++i) { s0[i] = __builtin_amdgcn_exp2f(s0[i] * c2 - shift); s1[i] = __builtin_amdgcn_exp2f(s1[i] * c2 - shift); }
                float ps = 0.f;
#pragma unroll
                for (int i = 0; i < 16; ++i) ps += s0[i] + s1[i];
                R += ps;
            }
            const bf16x8 p00 = pack_step(s0, 0), p01 = pack_step(s0, 1), p10 = pack_step(s1, 0), p11 = pack_step(s1, 1);
            const unsigned vb = v_lane + (unsigned)(b * STAGE);
#define ATT_PV(KB, ST, PF) do { \
            const s16x4 l0 = tr_read<((4 * KB + 2 * ST) * 4 + 0) * 512>(vb), h0 = tr_read<((4 * KB + 2 * ST + 1) * 4 + 0) * 512>(vb); \
            const s16x4 l1 = tr_read<((4 * KB + 2 * ST) * 4 + 1) * 512>(vb), h1 = tr_read<((4 * KB + 2 * ST + 1) * 4 + 1) * 512>(vb); \
            const s16x4 l2 = tr_read<((4 * KB + 2 * ST) * 4 + 2) * 512>(vb), h2 = tr_read<((4 * KB + 2 * ST + 1) * 4 + 2) * 512>(vb); \
            const s16x4 l3 = tr_read<((4 * KB + 2 * ST) * 4 + 3) * 512>(vb), h3 = tr_read<((4 * KB + 2 * ST + 1) * 4 + 3) * 512>(vb); \
            asm volatile("s_waitcnt lgkmcnt(0)" ::: "memory"); __builtin_amdgcn_sched_barrier(0); \
            o[0] = ATT_MFMA(__builtin_shufflevector(l0, h0, 0, 1, 2, 3, 4, 5, 6, 7), PF, o[0]); \
            o[1] = ATT_MFMA(__builtin_shufflevector(l1, h1, 0, 1, 2, 3, 4, 5, 6, 7), PF, o[1]); \
            o[2] = ATT_MFMA(__builtin_shufflevector(l2, h2, 0, 1, 2, 3, 4, 5, 6, 7), PF, o[2]); \
            o[3] = ATT_MFMA(__builtin_shufflevector(l3, h3, 0, 1, 2, 3, 4, 5, 6, 7), PF, o[3]); } while (0)
            ATT_PV(0, 0, p00); ATT_PV(0, 1, p01); ATT_PV(1, 0, p10); ATT_PV(1, 1, p11);
#undef ATT_PV
        }
        if (MODE == 0) { const unsigned dn = __all(R > 160.0f) ? 1u : 0u; if (lane == 0) flags[b * 8 + wave] = dn; }
    }
    float inv = 1.0f;
    if (MODE == 1) inv = 1.0f / (R + __shfl_xor(R, 32));
    unsigned short* op = O + (size_t)t * ldo + 4 * h;
#pragma unroll
    for (int d = 0; d < 4; ++d)
#pragma unroll
        for (int g = 0; g < 4; ++g) { u32x2 w; w.x = pg8::cvt_pk_bf16(o[d][4 * g] * inv, o[d][4 * g + 1] * inv); w.y = pg8::cvt_pk_bf16(o[d][4 * g + 2] * inv, o[d][4 * g + 3] * inv);
            *(u32x2*)(op + 32 * d + 8 * g) = w; }
#undef ATT_STAGE
}

template <int DQK>
__device__ __forceinline__ void attn_unit_sm3(ATT_LAS unsigned char* lds, const unsigned short* Q, int ldq, const unsigned short* K, int ldk, const unsigned short* V, int ldv, unsigned short* O, int ldo,
                                              int q0, int ntiles, int jd, float c2, float shift, int tid, int lane, int wave, const float* rc, const float* gq) {
    static_assert(DQK == 192, "padded K image below is laid out for 128 + 64 key dims");
    constexpr int NKS = DQK / 16, KA_BYTES = 64 * 272, KB_BYTES = 64 * 144, VOFF = KA_BYTES + KB_BYTES, STG = VOFF + 16384;
    static_assert(3 * STG <= 131072, "ring");
    const int r = lane & 31, h = lane >> 5;
    const int t = q0 + 32 * wave + r;
    const bool trail = wave >= 4;
    bf16x8 qf[NKS];
    load_q_norm<NKS, true>(qf, Q + (size_t)t * ldq, h, rc + (size_t)t * 64, gq, 1.0f / DQK, 1e-6f, c2);
    f32x16 o[4];
#pragma unroll
    for (int d = 0; d < 4; ++d)
#pragma unroll
        for (int i = 0; i < 16; ++i) o[d][i] = 0.f;
    float R = 0.f;
    int koff[4], voff[2];
    { const int qa0 = tid, qa1 = tid + 512, qb0 = tid;
      koff[0] = (qa0 / 17) * ldk + 8 * ((qa0 % 17) < 16 ? (qa0 % 17) : 0);
      koff[1] = (qa1 / 17) * ldk + 8 * ((qa1 % 17) < 16 ? (qa1 % 17) : 0);
      koff[2] = (qb0 / 9) * ldk + 128 + 8 * ((qb0 % 9) < 8 ? (qb0 % 9) : 0);
      const int qx = (wave == 0) ? 1024 + lane : 512 + lane;
      koff[3] = (wave == 0) ? (qx / 17) * ldk + 8 * ((qx % 17) < 16 ? (qx % 17) : 0) : (qx / 9) * ldk + 128 + 8 * ((qx % 9) < 8 ? (qx % 9) : 0); }
#pragma unroll
    for (int i = 0; i < 2; ++i) { const int cidx = tid + 512 * i; voff[i] = (8 * (cidx >> 7) + ((cidx >> 2) & 7)) * ldv + 32 * ((cidx >> 5) & 3) + 8 * (cidx & 3); }
    const unsigned ldsw = (unsigned)wave * 1024u;
#define ATT_DMA(src, dstoff) __builtin_amdgcn_global_load_lds((const unsigned*)(src), (ATT_LAS unsigned*)(lds + (dstoff)), 16, 0, 0)
#define ATT_STAGE3(j, sg) do { const unsigned short* kt_ = K + (size_t)(j) * 64 * ldk; const unsigned short* vt_ = V + (size_t)(j) * 64 * ldv; \
        ATT_DMA(kt_ + koff[0], (sg) * STG + ldsw); ATT_DMA(kt_ + koff[1], (sg) * STG + 8192 + ldsw); ATT_DMA(kt_ + koff[2], (sg) * STG + KA_BYTES + ldsw); \
        if (wave == 0) ATT_DMA(kt_ + koff[3], (sg) * STG + 16384); else if (wave == 1) ATT_DMA(kt_ + koff[3], (sg) * STG + KA_BYTES + 8192); \
        ATT_DMA(vt_ + voff[0], (sg) * STG + VOFF + ldsw); ATT_DMA(vt_ + voff[1], (sg) * STG + VOFF + 8192 + ldsw); } while (0)
    const unsigned lds0 = (unsigned)(size_t)lds;
    const unsigned ka_lane = lds0 + (unsigned)(r * 272 + h * 16), kb_lane = lds0 + (unsigned)(KA_BYTES + r * 144 + h * 16);
    const unsigned v_lane = lds0 + VOFF + (unsigned)((4 * h + ((lane & 15) >> 2)) * 64 + 32 * ((lane >> 4) & 1) + 8 * (lane & 3));

    ATT_STAGE3(0, 0);
    if (ntiles > 1) ATT_STAGE3(1, 1);
    asm volatile("s_waitcnt vmcnt(0)" ::: "memory");
    if (trail) __builtin_amdgcn_s_barrier();
    __builtin_amdgcn_s_barrier();
    int sc = 0;
    for (int j = 0; j < ntiles; ++j) {
        f32x16 s0, s1; bf16x8 p00, p01;
        if (j <= jd) {
#pragma unroll
            for (int i = 0; i < 16; ++i) { s0[i] = 0.f; s1[i] = 0.f; }
#define ATT_KRD_IMM(dst, addr, IMM) asm volatile("ds_read_b128 %0, %1 offset:%2" : "=&v"(dst) : "v"(addr), "i"(IMM) : "memory")
#define ATT_KRDF(dst, F) do { if (((F) % 12) < 8) ATT_KRD_IMM(dst, kaA, ((F) / 12) * (32 * 272) + ((F) % 12) * 32); \
            else ATT_KRD_IMM(dst, kaB, ((F) / 12) * (32 * 144) + ((((F) % 12) >= 8) ? ((F) % 12 - 8) : 0) * 32); } while (0)
#define ATT_A_STEP(F) do { \
            if ((F) + 3 < 24) { ATT_KRDF(kf[((F) + 3) & 3], (F) + 3); asm volatile("s_waitcnt lgkmcnt(3)" ::: "memory"); } \
            else if ((F) + 3 == 24) asm volatile("s_waitcnt lgkmcnt(2)" ::: "memory"); \
            else if ((F) + 2 == 24) asm volatile("s_waitcnt lgkmcnt(1)" ::: "memory"); \
            else asm volatile("s_waitcnt lgkmcnt(0)" ::: "memory"); \
            __builtin_amdgcn_sched_barrier(0); \
            if ((F) < 12) s0 = ATT_MFMA(kf[(F) & 3], qf[(F) % 12], s0); else s1 = ATT_MFMA(kf[(F) & 3], qf[(F) % 12], s1); \
            __builtin_amdgcn_sched_barrier(0); \
            if ((F) > 12) { _Pragma("unroll") for (int e_ = (16 * ((F) - 13)) / 11; e_ < (16 * ((F) - 12)) / 11; ++e_) { s0[e_] = __builtin_amdgcn_exp2f(s0[e_]); if (e_ & 1) psb += s0[e_]; else psa += s0[e_]; } \
                __builtin_amdgcn_sched_barrier(0); } } while (0)
            const unsigned kaA = ka_lane + (unsigned)(sc * STG), kaB = kb_lane + (unsigned)(sc * STG);
            bf16x8 kf[4];
            ATT_KRDF(kf[0], 0); ATT_KRDF(kf[1], 1); ATT_KRDF(kf[2], 2);
            float psa = 0.f, psb = 0.f;
            ATT_A_STEP(0); ATT_A_STEP(1); ATT_A_STEP(2); ATT_A_STEP(3); ATT_A_STEP(4); ATT_A_STEP(5); ATT_A_STEP(6); ATT_A_STEP(7); ATT_A_STEP(8); ATT_A_STEP(9); ATT_A_STEP(10); ATT_A_STEP(11);
            ATT_A_STEP(12); ATT_A_STEP(13); ATT_A_STEP(14); ATT_A_STEP(15); ATT_A_STEP(16); ATT_A_STEP(17); ATT_A_STEP(18); ATT_A_STEP(19); ATT_A_STEP(20); ATT_A_STEP(21); ATT_A_STEP(22); ATT_A_STEP(23);
            R += psa + psb;
#undef ATT_KRD_IMM
#undef ATT_KRDF
#undef ATT_A_STEP
            p00 = pack_step(s0, 0); p01 = pack_step(s0, 1);
        }
        asm volatile("s_waitcnt vmcnt(0)" ::: "memory");
        __builtin_amdgcn_s_barrier();
        if (j + 2 < ntiles) { const int sn = sc == 0 ? 2 : sc - 1; ATT_STAGE3(j + 2, sn); }
        if (j <= jd) {
            const unsigned vb = v_lane + (unsigned)(sc * STG);
#define ATT_VLD(KB, ST, D, L, H) do { \
            L[0] = tr_read<((4 * KB + 2 * ST) * 4 + D) * 512>(vb); H[0] = tr_read<((4 * KB + 2 * ST + 1) * 4 + D) * 512>(vb); \
            L[1] = tr_read<((4 * KB + 2 * ST) * 4 + D + 1) * 512>(vb); H[1] = tr_read<((4 * KB + 2 * ST + 1) * 4 + D + 1) * 512>(vb); } while (0)
#define ATT_PVM(D, L, H, PF) do { \
            o[D] = ATT_MFMA(__builtin_shufflevector(L[0], H[0], 0, 1, 2, 3, 4, 5, 6, 7), PF, o[D]); \
            o[D + 1] = ATT_MFMA(__builtin_shufflevector(L[1], H[1], 0, 1, 2, 3, 4, 5, 6, 7), PF, o[D + 1]); } while (0)
#define ATT_W(n) do { asm volatile("s_waitcnt lgkmcnt(" #n ")" ::: "memory"); __builtin_amdgcn_sched_barrier(0); } while (0)
#define ATT_SM1(E0) do { __builtin_amdgcn_sched_barrier(0); _Pragma("unroll") for (int e_ = (E0); e_ < (E0) + 4; ++e_) { s1[e_] = __builtin_amdgcn_exp2f(s1[e_]); if (e_ & 1) psb += s1[e_]; else psa += s1[e_]; } \
            __builtin_amdgcn_sched_barrier(0); } while (0)
            float psa = 0.f, psb = 0.f;
            s16x4 la[2], ha[2], lb[2], hb[2], lc[2], hc[2];
            ATT_VLD(0, 0, 0, la, ha); ATT_VLD(0, 0, 2, lb, hb);
            ATT_VLD(0, 1, 0, lc, hc); ATT_W(8); ATT_PVM(0, la, ha, p00); ATT_SM1(0);
            ATT_VLD(0, 1, 2, la, ha); ATT_W(8); ATT_PVM(2, lb, hb, p00); ATT_SM1(4);
            ATT_VLD(1, 0, 0, lb, hb); ATT_W(8); ATT_PVM(0, lc, hc, p01); ATT_SM1(8);
            ATT_VLD(1, 0, 2, lc, hc); ATT_W(8); ATT_PVM(2, la, ha, p01); ATT_SM1(12);
            R += psa + psb;
            const bf16x8 p10 = pack_step(s1, 0);
            ATT_VLD(1, 1, 0, la, ha); ATT_W(8); ATT_PVM(0, lb, hb, p10); __builtin_amdgcn_sched_barrier(0);
            ATT_VLD(1, 1, 2, lb, hb); ATT_W(8); ATT_PVM(2, lc, hc, p10); __builtin_amdgcn_sched_barrier(0);
            const bf16x8 p11 = pack_step(s1, 1);
            ATT_W(4); ATT_PVM(0, la, ha, p11); __builtin_amdgcn_sched_barrier(0);
            ATT_W(0); ATT_PVM(2, lb, hb, p11);
#undef ATT_SM1
#undef ATT_VLD
#undef ATT_PVM
#undef ATT_W
        }
        __builtin_amdgcn_s_barrier();
        sc = sc == 2 ? 0 : sc + 1;
    }
    if (!trail) __builtin_amdgcn_s_barrier();
    const float inv = 1.0f / (R + __shfl_xor(R, 32));
    unsigned short* op = O + (size_t)t * ldo + 4 * h;
#pragma unroll
    for (int d = 0; d < 4; ++d)
#pragma unroll
        for (int g = 0; g < 4; ++g) { u32x2 w; w.x = pg8::cvt_pk_bf16(o[d][4 * g] * inv, o[d][4 * g + 1] * inv); w.y = pg8::cvt_pk_bf16(o[d][4 * g + 2] * inv, o[d][4 * g + 3] * inv);
            *(u32x2*)(op + 32 * d + 8 * g) = w; }
#undef ATT_STAGE3
#undef ATT_DMA
}
}


#ifndef NLAUNCH
#define NLAUNCH 1
#endif
constexpr int NWAVES = 8, NPH = 10;
constexpr int S = 8192, D = 4096, NMEM = 256, NIN = 19392, NP = 19456, DFF = 16384;
constexpr int C_SBQ = 0, C_SBK = 1536, C_SBV = 3072, C_CQ = 4608, C_CKV = 5504, C_KPE = 6016, C_PAD = 6080, C_MEMQ = 6144, C_GATE = 7168;
constexpr int QLORA = 896, KVLORA = 512, NQB = 2304, NKVB = 3072, MEMW = 1024;
constexpr float EPS = 1e-6f;
#ifndef LDU
#define LDU (DFF + 64)
#endif

#define GAS __attribute__((address_space(1)))
#define LAS __attribute__((address_space(3)))
typedef unsigned short bf16;
typedef unsigned u32x4 __attribute__((ext_vector_type(4)));
typedef float f32x4 __attribute__((ext_vector_type(4)));

constexpr size_t MiB = 1u << 20;
constexpr size_t WS_CTL = 0, CTL_ZERO_BYTES = 1 * MiB, CTL_SSQ_OFF = 512 * 1024;
constexpr size_t WS_WIN = 1 * MiB, WS_WFF1 = 153 * MiB, WS_WFF2 = 281 * MiB, WS_WOUT = 409 * MiB, WS_WSBO = 441 * MiB, WS_WMLAO = 453 * MiB, WS_WMEMO = 465 * MiB,
                 WS_WMEMKV = 473 * MiB, WS_WQB = 489 * MiB, WS_WKVB = 493 * MiB;
constexpr size_t WS_H = 496 * MiB, WS_QRAW = 560 * MiB, WS_KVRAW = 596 * MiB, WS_PACC = WS_H  ;
constexpr size_t WS_PROJ = 644 * MiB, WS_U = WS_PROJ  ;
constexpr size_t WS_HM = 948 * MiB, WS_CQN = 950 * MiB, WS_CKVN = 964 * MiB, WS_KROT = 972 * MiB, WS_ROPECS = 974 * MiB, WS_QF = 976 * MiB, WS_KF = 1012 * MiB, WS_QM = 1048 * MiB,
                 WS_MKV = 1064 * MiB, WS_MKF = 1065 * MiB, WS_OSB = 1066 * MiB, WS_OMLA = 1090 * MiB, WS_OMEM = 1114 * MiB, WS_END = 1130 * MiB;
constexpr size_t WS_WCAT = WS_WSBO, WS_OCAT = WS_OSB;
constexpr size_t WS_X1B = WS_H;
constexpr size_t WS_MERGED = WS_WIN, WS_XG = WS_WIN + 64 * MiB;
static_assert(WS_WIN + (size_t)NP * D * 2 <= WS_WFF1 && WS_PACC + (size_t)S * D * 4 <= WS_PROJ && WS_PROJ + (size_t)S * NP * 2 <= WS_HM && WS_U + (size_t)S * (DFF + 64) * 2 <= WS_HM, "ws map");
static_assert(WS_XG + (size_t)S * D * 2 <= WS_WFF1 && WS_QRAW + (size_t)S * NQB * 2 <= WS_KVRAW && WS_KVRAW + (size_t)S * NKVB * 2 <= WS_PROJ, "ws map 2");
constexpr int CW_BAR = 4096;

constexpr int RING_BYTES = 131072, LDSCTL_OFF = RING_BYTES, LDS_BYTES = 147456;

#define XB_TMO      128
#define XB_XCNT(j)  (256  + 64 * (j))
#define XB_XSUB(j)  (1280 + 64 * (j))
#define XB_XGEN(j)  (2304 + 64 * (j))
#define XB_TOP      3328
#define XB_TOPGEN   3392
#define XCD_BAR_WORDS 3456
#define XB_SPIN_CAP (1u << 18)
__device__ __forceinline__ unsigned xb_ld(unsigned* p)              { return __hip_atomic_load(p, __ATOMIC_RELAXED, __HIP_MEMORY_SCOPE_AGENT); }
__device__ __forceinline__ unsigned xb_add(unsigned* p, unsigned v) { return __hip_atomic_fetch_add(p, v, __ATOMIC_RELAXED, __HIP_MEMORY_SCOPE_AGENT); }
__device__ __forceinline__ unsigned xb_xcc_id() { return (unsigned)__builtin_amdgcn_s_getreg((3 << 11) | 20) & 0xFu; }
#define XB_SPIN(cond, bar) do { unsigned _sp = 0; while (cond) { __builtin_amdgcn_s_sleep(1); \
    if ((++_sp & 255u) == 0u) { if (xb_ld(&(bar)[XB_TMO])) break; if (_sp > XB_SPIN_CAP) { atomicAdd(&(bar)[XB_TMO], 1u); break; } } } } while (0)
struct XcdBarrier { unsigned* bar; unsigned x; volatile LAS unsigned* st; };
__device__ __forceinline__ XcdBarrier xcd_barrier_post(unsigned* bar, volatile LAS unsigned* st) {
    XcdBarrier b; b.bar = bar; b.x = xb_xcc_id(); b.st = st;
    if (threadIdx.x == 0) (void)xb_add(&bar[XB_XCNT(b.x)], 1u);
    return b;
}
__device__ __forceinline__ void xcd_barrier_complete(unsigned* bar, unsigned x, unsigned& nloc, unsigned& nx) {
    const unsigned G = gridDim.x * gridDim.y * gridDim.z;
    unsigned sum, cnt, mine, sp = 0u;
    for (;;) {
        sum = 0u; cnt = 0u; mine = 0u;
#pragma unroll
        for (unsigned j = 0; j < 16; ++j) { const unsigned c = xb_ld(&bar[XB_XCNT(j)]); sum += c; cnt += (c > 0u) ? 1u : 0u; mine = (j == x) ? c : mine; }
        if (sum == G) break;
        __builtin_amdgcn_s_sleep(1);
        if ((++sp & 255u) == 0u) { if (xb_ld(&bar[XB_TMO])) break; if (sp > XB_SPIN_CAP) { atomicAdd(&bar[XB_TMO], 1u); break; } }
    }
    nloc = mine > 0u ? mine : 1u; nx = cnt > 0u ? cnt : 1u;
}
__device__ __forceinline__ void xcd_barrier(const XcdBarrier& b) {
    asm volatile("s_waitcnt vmcnt(0)" ::: "memory");
    __syncthreads();
    if (threadIdx.x == 0) {
        unsigned* bar = b.bar;
        __builtin_amdgcn_s_waitcnt(0);
        unsigned nloc = b.st[0], nx = b.st[1];
        if (nloc == 0u) { xcd_barrier_complete(bar, b.x, nloc, nx); b.st[0] = nloc; b.st[1] = nx; }
        const unsigned old = xb_add(&bar[XB_XSUB(b.x)], 1u);
        const unsigned gen = old / nloc;
        if (old + 1u == (gen + 1u) * nloc) {
            __builtin_amdgcn_fence(__ATOMIC_RELEASE, "agent");
            asm volatile("s_waitcnt vmcnt(0)" ::: "memory");
            const unsigned og = xb_add(&bar[XB_TOP], 1u);
            const unsigned tg = og / nx;
            if (og + 1u == (tg + 1u) * nx) xb_add(&bar[XB_TOPGEN], 1u);
            else XB_SPIN(xb_ld(&bar[XB_TOPGEN]) == tg, bar);
            __builtin_amdgcn_fence(__ATOMIC_ACQUIRE, "agent");
            xb_add(&bar[XB_XGEN(b.x)], 1u);
            asm volatile("s_waitcnt vmcnt(0)" ::: "memory");
        } else {
            XB_SPIN(xb_ld(&bar[XB_XGEN(b.x)]) == gen, bar);
            __builtin_amdgcn_fence(__ATOMIC_ACQUIRE, "agent");
            asm volatile("s_waitcnt vmcnt(0)" ::: "memory");
        }
    }
    __syncthreads();
}

__device__ __forceinline__ float bf2f_lo(unsigned w) { return __builtin_bit_cast(float, w << 16); }
__device__ __forceinline__ float bf2f_hi(unsigned w) { return __builtin_bit_cast(float, w & 0xffff0000u); }
__device__ __forceinline__ void unpack8(const u32x4 w, float (&v)[8]) { v[0] = bf2f_lo(w.x); v[1] = bf2f_hi(w.x); v[2] = bf2f_lo(w.y); v[3] = bf2f_hi(w.y); v[4] = bf2f_lo(w.z); v[5] = bf2f_hi(w.z); v[6] = bf2f_lo(w.w); v[7] = bf2f_hi(w.w); }
__device__ __forceinline__ u32x4 pack8(const float (&v)[8]) { u32x4 w; w.x = pg8::cvt_pk_bf16(v[0], v[1]); w.y = pg8::cvt_pk_bf16(v[2], v[3]); w.z = pg8::cvt_pk_bf16(v[4], v[5]); w.w = pg8::cvt_pk_bf16(v[6], v[7]); return w; }
__device__ __forceinline__ float wave_sum(float v) {
#pragma unroll
    for (int o = 1; o < 64; o <<= 1) v += __shfl_xor(v, o);
    return v;
}
__device__ __forceinline__ float half_sum(float v) {
#pragma unroll
    for (int o = 1; o < 32; o <<= 1) v += __shfl_xor(v, o);
    return v;
}

struct Args { const float* in[22]; float* out; unsigned char* ws; int ph_lo, ph_hi, li, pad; };

#ifndef P9_WGM
#define P9_WGM 8
#endif
#ifndef FF1_DEFER
#define FF1_DEFER 0
#endif
__device__ __forceinline__ void tr_tile(const float* __restrict__ W, int K, int N, bf16* __restrict__ WT, int ldt, int dst_row, int k0, int kdst, int n0, LAS unsigned char* scr, int lane, const float* kscale = nullptr) {
    const int nc = lane & 15, kp0 = lane >> 4;
    f32x4 va[8], vb[8];
#pragma unroll
    for (int i = 0; i < 8; ++i) { const float* p = W + (size_t)(k0 + 2 * (kp0 + 4 * i)) * N + n0 + 4 * nc; va[i] = *(const f32x4*)p; vb[i] = *(const f32x4*)(p + N); }
#pragma unroll
    for (int i = 0; i < 8; ++i) { const int kp = kp0 + 4 * i;
        if (kscale) { const float s0 = kscale[k0 + 2 * kp], s1 = kscale[k0 + 2 * kp + 1]; va[i] = va[i] * s0; vb[i] = vb[i] * s1; }
#pragma unroll
        for (int j = 0; j < 4; ++j) { const int n = 4 * nc + j;
            *(LAS unsigned*)(scr + n * 128 + (((kp >> 2) ^ (nc & 7)) << 4) + ((kp & 3) << 2)) = pg8::cvt_pk_bf16(va[i][j], vb[i][j]); } }
    asm volatile("s_waitcnt lgkmcnt(0)" ::: "memory");
    const int c = lane & 7;
#pragma unroll
    for (int jj = 0; jj < 8; ++jj) { const int n = (lane >> 3) + 8 * jj;
        const u32x4 v = *(const LAS u32x4*)(scr + n * 128 + ((c ^ ((n >> 2) & 7)) << 4));
        *(u32x4*)(WT + (size_t)(dst_row + n) * ldt + kdst + 8 * c) = v; }
    asm volatile("s_waitcnt lgkmcnt(0)" ::: "memory");
}
__device__ __forceinline__ bool tr_mat(int& r, const float* W, int K, int N, bf16* WT, bool is_win, LAS unsigned char* scr, int lane, int ldt = 0, int koff = 0, const float* kscale = nullptr) {
    const int nb = N / 64, items = (K / 64) * nb;
    if (r >= items) { r -= items; return false; }
    const int kb = r / nb, n0 = (r % nb) * 64;
    tr_tile(W, K, N, WT, ldt ? ldt : K, is_win ? (n0 + (n0 >= C_PAD ? 64 : 0)) : n0, kb * 64, koff + kb * 64, n0, scr, lane, kscale);
    return true;
}
struct TrDesc { const float* W; bf16* WT; int N, ldt, dst_row, k0, kdst, n0; };
__device__ __forceinline__ void tr_load(const TrDesc& d, f32x4 (&va)[8], f32x4 (&vb)[8], int lane) {
    const int nc = lane & 15, kp0 = lane >> 4;
#pragma unroll
    for (int i = 0; i < 8; ++i) { const float* p = d.W + (size_t)(d.k0 + 2 * (kp0 + 4 * i)) * d.N + d.n0 + 4 * nc; va[i] = *(const f32x4*)p; vb[i] = *(const f32x4*)(p + d.N); }
}
__device__ __forceinline__ void tr_store(const TrDesc& d, const f32x4 (&va)[8], const f32x4 (&vb)[8], LAS unsigned char* scr, int lane) {
    const int nc = lane & 15, kp0 = lane >> 4;
#pragma unroll
    for (int i = 0; i < 8; ++i) { const int kp = kp0 + 4 * i;
#pragma unroll
        for (int j = 0; j < 4; ++j) { const int n = 4 * nc + j;
            *(LAS unsigned*)(scr + n * 128 + (((kp >> 2) ^ (nc & 7)) << 4) + ((kp & 3) << 2)) = pg8::cvt_pk_bf16(va[i][j], vb[i][j]); } }
    asm volatile("s_waitcnt lgkmcnt(0)" ::: "memory");
    const int c = lane & 7;
#pragma unroll
    for (int jj = 0; jj < 8; ++jj) { const int n = (lane >> 3) + 8 * jj;
        const u32x4 v = *(const LAS u32x4*)(scr + n * 128 + ((c ^ ((n >> 2) & 7)) << 4));
        *(u32x4*)(d.WT + (size_t)(d.dst_row + n) * d.ldt + d.kdst + 8 * c) = v; }
    asm volatile("s_waitcnt lgkmcnt(0)" ::: "memory");
}
__device__ __forceinline__ bool tr_desc_mat(int& r, TrDesc& d, const float* W, int K, int N, bf16* WT, bool is_win) {
    const int nb = N / 64, items = (K / 64) * nb;
    if (r >= items) { r -= items; return false; }
    const int kb = r / nb, n0 = (r % nb) * 64;
    d.W = W; d.WT = WT; d.N = N; d.ldt = K; d.dst_row = is_win ? (n0 + (n0 >= C_PAD ? 64 : 0)) : n0; d.k0 = kb * 64; d.kdst = kb * 64; d.n0 = n0;
    return true;
}
__device__ __forceinline__ void rms_row_4096(const float* xrow, const float* g, bf16* orow, int lane) {
    const f32x4* xr = (const f32x4*)xrow + lane; f32x4 v[16]; float s = 0.f;
#pragma unroll
    for (int j = 0; j < 16; ++j) { v[j] = xr[64 * j]; s += (v[j].x * v[j].x + v[j].y * v[j].y) + (v[j].z * v[j].z + v[j].w * v[j].w); }
    const float rstd = 1.0f / __builtin_sqrtf(wave_sum(s) * (1.0f / 4096.0f) + EPS);
    unsigned long long* o8 = (unsigned long long*)orow + lane;
#pragma unroll
    for (int j = 0; j < 16; ++j) { const f32x4 gg = ((const f32x4*)g)[lane + 64 * j];
        o8[64 * j] = (unsigned long long)pg8::cvt_pk_bf16(v[j].x * rstd * gg.x, v[j].y * rstd * gg.y) | ((unsigned long long)pg8::cvt_pk_bf16(v[j].z * rstd * gg.z, v[j].w * rstd * gg.w) << 32); }
}
template <int WHICH>
__device__ __forceinline__ void tr_pipeline(const Args& a, LAS unsigned char* scr, int gw, int NGW, int lane, int it0 = 0, int it1 = 1 << 30) {
    unsigned char* ws = a.ws;
    constexpr int NALL = WHICH == 0 ? 64 * 303 + 64 * 32 : 64 * 256;
    const int NITEMS = it1 < NALL ? it1 : NALL;
    gw += it0;
    auto desc = [&](int it, TrDesc& d) { int r = it;
        if (WHICH == 0) { if (tr_desc_mat(r, d, a.in[5], D, NIN, (bf16*)(ws + WS_WIN), true)) return;
                          tr_desc_mat(r, d, a.in[12], D, 2048, (bf16*)(ws + WS_WMEMKV), false); }
        else if (WHICH == 1) tr_desc_mat(r, d, a.in[20], D, DFF, (bf16*)(ws + WS_WFF1), false);
        else tr_desc_mat(r, d, a.in[21], DFF, D, (bf16*)(ws + WS_WFF2), false); };
    if (gw < NITEMS) {
        TrDesc d0; f32x4 va[8], vb[8];
        desc(gw, d0); tr_load(d0, va, vb, lane);
        for (int it = gw; it < NITEMS; it += NGW) {
            TrDesc d1 = d0; f32x4 na[8], nb[8];
            const bool more = it + NGW < NITEMS;
            if (more) { desc(it + NGW, d1); tr_load(d1, na, nb, lane); }
            tr_store(d0, va, vb, scr, lane);
            if (more) { d0 = d1;
#pragma unroll
                for (int i = 0; i < 8; ++i) { va[i] = na[i]; vb[i] = nb[i]; } }
        }
    }
}
__device__ __forceinline__ void p0_prologue(const Args& a, LAS unsigned char* lds, int gw, int NGW, int wave, int lane) {
    unsigned char* ws = a.ws;
    LAS unsigned char* scr = lds + wave * 8192;
    tr_pipeline<0>(a, scr, gw, NGW, lane);
    for (int i = gw * 64 + lane; i < 64 * D * 2 / 16; i += NGW * 64) ((u32x4*)(ws + WS_WIN + (size_t)C_PAD * D * 2))[i] = (u32x4){0u, 0u, 0u, 0u};
    for (int m = gw; m < S; m += NGW) rms_row_4096(a.in[0] + (size_t)m * D, a.in[3], (bf16*)(ws + WS_H) + (size_t)m * D, lane);
    for (int m = gw; m < NMEM; m += NGW) rms_row_4096(a.in[1] + (size_t)m * D, a.in[4], (bf16*)(ws + WS_HM) + (size_t)m * D, lane);
    {
        const int* pos = (const int*)a.in[2]; const int c = lane & 31;
        const double freq = exp2(-(double)c * (13.287712379549449 / 32.0));
        for (int r = 2 * gw + (lane >> 5); r < S; r += 2 * NGW) { double sn_, cs_; sincos((double)pos[r] * freq, &sn_, &cs_);
            float* rcw = (float*)(ws + WS_ROPECS) + (size_t)r * 64; rcw[c] = (float)cs_; rcw[32 + c] = (float)sn_; } }
}

__device__ __forceinline__ void p1_deferred_convert(const Args& a, LAS unsigned char* lds, int gw2, int NGW2, int wave, int lane) {
    unsigned char* ws = a.ws;
    LAS unsigned char* scr = lds + wave * 8192;
    constexpr int NITEMS = 64 * 64 + 24 * 64 + 24 * 64 + 16 * 64 + 14 * 36 + 8 * 48 + FF1_DEFER;
    for (int it = gw2; it < NITEMS; it += NGW2) {
        int r = it;
        if (tr_mat(r, a.in[8], QLORA, NQB, (bf16*)(ws + WS_WQB), false, scr, lane, 0, 0, a.in[6])) continue;
        if (tr_mat(r, a.in[9], KVLORA, NKVB, (bf16*)(ws + WS_WKVB), false, scr, lane, 0, 0, a.in[7])) continue;
        if (tr_mat(r, a.in[15], 1536, D, (bf16*)(ws + WS_WCAT), false, scr, lane, D, 0)) continue;
        if (tr_mat(r, a.in[16], 1536, D, (bf16*)(ws + WS_WCAT), false, scr, lane, D, 1536)) continue;
        if (tr_mat(r, a.in[17], 1024, D, (bf16*)(ws + WS_WCAT), false, scr, lane, D, 3072)) continue;
        if (tr_mat(r, a.in[18], D, D, (bf16*)(ws + WS_WOUT), false, scr, lane)) continue;
        tr_mat(r, a.in[20], D, DFF, (bf16*)(ws + WS_WFF1), false, scr, lane);
    }
}

__device__ __forceinline__ void k_finalize_tile(const Args& a, int pm, int hh, int wave, int lane) {
    unsigned char* ws = a.ws;
    const int c = lane & 31, hsel = lane >> 5;
    const int cc = c < 24 ? c : 23;
    float gkv[8];
#pragma unroll
    for (int i = 0; i < 8; ++i) gkv[i] = a.in[11][8 * cc + i];
    const int ib = 8 * ((cc - 16) & 3); const float sg = cc < 20 ? -1.f : 1.f;
#pragma unroll 2
    for (int it = 0; it < 16; ++it) {
        const int r = pm * 256 + wave * 32 + 2 * it + hsel;
        const bf16* pr = (const bf16*)(ws + WS_PROJ) + (size_t)r * NP;
        const u32x4 kn = *(const u32x4*)((const bf16*)(ws + WS_KVRAW) + (size_t)r * NKVB + hh * 256 + 8 * (cc & 15));
        const u32x4 kpw = *(const u32x4*)(pr + C_KPE + 8 * ((cc - 16) & 7));
        const float* rc = (const float*)(ws + WS_ROPECS) + (size_t)r * 64 + ib;
        const f32x4 c0 = *(const f32x4*)rc, c1 = *(const f32x4*)(rc + 4), s0 = *(const f32x4*)(rc + 32), s1 = *(const f32x4*)(rc + 36);
        float v[8];
        if (cc < 16) unpack8(kn, v);
        else { float kp[8]; unpack8(kpw, kp);
#pragma unroll
            for (int i = 0; i < 8; ++i) v[i] = kp[i]; }
        float pk[8];
#pragma unroll
        for (int i = 0; i < 8; ++i) pk[i] = __shfl_xor(v[i], 4);
        if (cc >= 16) {
#pragma unroll
            for (int i = 0; i < 8; ++i) { const float cs_ = i < 4 ? c0[i & 3] : c1[i & 3], sn_ = i < 4 ? s0[i & 3] : s1[i & 3]; v[i] = v[i] * cs_ + sg * pk[i] * sn_; } }
        float ss = 0.f;
#pragma unroll
        for (int i = 0; i < 8; ++i) ss += v[i] * v[i];
        if (c >= 24) ss = 0.f;
        const float rstd = 1.0f / __builtin_sqrtf(half_sum(ss) * (1.0f / 192.0f) + EPS);
#pragma unroll
        for (int i = 0; i < 8; ++i) v[i] *= rstd * gkv[i];
        if (c < 24) *(u32x4*)((bf16*)(ws + WS_KF) + (size_t)r * NQB + hh * 192 + 8 * c) = pack8(v);
    }
}
__device__ __forceinline__ void mk_finalize_tile(const Args& a, int hh, int wave, int lane) {
    unsigned char* ws = a.ws;
    const int c = lane & 31, hsel = lane >> 5;
    float gmv[8];
#pragma unroll
    for (int i = 0; i < 8; ++i) gmv[i] = a.in[14][8 * c + i] * a.in[13][8 * c + i];
#pragma unroll 2
    for (int it = 0; it < 16; ++it) {
        const int r = wave * 32 + 2 * it + hsel;
        float v[8]; unpack8(*(const u32x4*)((const bf16*)(ws + WS_MKV) + (size_t)r * 2048 + hh * 256 + 8 * c), v);
        float ss = 0.f;
#pragma unroll
        for (int i = 0; i < 8; ++i) ss += v[i] * v[i];
        const float rstd = 1.0f / __builtin_sqrtf(half_sum(ss) * (1.0f / 256.0f) + EPS);
#pragma unroll
        for (int i = 0; i < 8; ++i) v[i] *= rstd * gmv[i];
        *(u32x4*)((bf16*)(ws + WS_MKF) + (size_t)r * MEMW + hh * 256 + 8 * c) = pack8(v);
    }
}

constexpr int CW_QUEUE = 8192;
__device__ __forceinline__ int next_unit(unsigned* ctr, volatile LAS unsigned* slot, int tid) {
    __syncthreads();
    if (tid == 0) *slot = atomicAdd(ctr, 1u);
    __syncthreads();
    return __builtin_amdgcn_readfirstlane((int)*slot);
}
__device__ __forceinline__ void p5_attention(const Args& a, LAS unsigned char* lds, int tid, int lane, int wave, int qsel) {
    unsigned char* ws = a.ws;
    const bf16* proj = (const bf16*)(ws + WS_PROJ);
    volatile LAS unsigned* flags = (volatile LAS unsigned*)(lds + LDSCTL_OFF + 128);
    volatile LAS unsigned* slot = (volatile LAS unsigned*)(lds + LDSCTL_OFF + 256);
    unsigned* qc = (unsigned*)(ws + WS_CTL) + CW_QUEUE + 1024 * qsel;
    float gq = 0.f, gk = 0.f, gm = 0.f;
    for (int i = lane; i < 192; i += 64) { gq = __builtin_fmaxf(gq, __builtin_fabsf(a.in[10][i])); gk = __builtin_fmaxf(gk, __builtin_fabsf(a.in[11][i])); }
    for (int i = lane; i < 256; i += 64) gm = __builtin_fmaxf(gm, __builtin_fabsf(a.in[13][i] * a.in[14][i]));
#pragma unroll
    for (int o = 1; o < 64; o <<= 1) { gq = __builtin_fmaxf(gq, __shfl_xor(gq, o)); gk = __builtin_fmaxf(gk, __shfl_xor(gk, o)); gm = __builtin_fmaxf(gm, __shfl_xor(gm, o)); }
    const float shift_mla = 13.8564064606f * gq * gk * 1.44269504089f, shift_mem = 16.0f * gm * 1.44269504089f;
    const int xcc = (int)(xb_xcc_id() & 7u);
    for (;;) {
        __syncthreads();
        if (tid == 0) { int code = -1;
            for (int k = 0; k < 8; ++k) { const int xq = (xcc + k) & 7; const unsigned i = atomicAdd(qc + 64 * xq, 1u); if (i < 48u) { code = xq * 64 + (int)i; break; } }
            *slot = (unsigned)code; }
        __syncthreads();
        const int code = __builtin_amdgcn_readfirstlane((int)*slot); if (code < 0) break;
        const int xq = code >> 6, qi = code & 63, m = 15 - qi / 3, pos = qi % 3;
        const int hh = pos == 1 ? 8 + (xq >> 1) : xq, qb = pos == 0 ? 2 * m + 1 : (pos == 2 ? 2 * m : 2 * m + 1 - (xq & 1));
        att::attn_unit_sm3<192>(lds, (const bf16*)(ws + WS_QRAW) + hh * 192, NQB, (const bf16*)(ws + WS_KF) + hh * 192, NQB, (const bf16*)(ws + WS_KVRAW) + hh * 256 + 128, NKVB,
                                (bf16*)(ws + WS_OCAT) + 1536 + hh * 128, D, 256 * qb, 4 * qb + 4, 4 * qb + (wave >> 1), 0.07216878364870322f * 1.44269504089f, shift_mla, tid, lane, wave, (const float*)(ws + WS_ROPECS), a.in[10]);
    }
    for (;;) {
        const int u = next_unit(qc + 64 * 8, slot, tid); if (u >= 12 * 32) break;
        const int hh = u % 12, qb = 31 - u / 12;
        att::attn_unit<0, 128>(lds, proj + C_SBQ + hh * 128, NP, proj + C_SBK + hh * 128, NP, proj + C_SBV + hh * 128, NP,
                               (bf16*)(ws + WS_OCAT) + hh * 128, D, 256 * qb, 4 * qb + 3, -1, 4 * qb + 4, 4 * qb + (wave >> 1), 0.08838834764831845f * 1.44269504089f, 0.f, flags, tid, lane, wave);
    }
    for (;;) {
        const int u = next_unit(qc + 64 * 9, slot, tid); if (u >= 4 * 2 * 32) break;
        const int hh = u & 3, dvh = (u >> 2) & 1, qb = u >> 3;
        att::attn_unit<1, 256, true>(lds, proj + C_MEMQ + hh * 256, NP, (const bf16*)(ws + WS_MKF) + hh * 256, MEMW, (const bf16*)(ws + WS_MKV) + 1024 + hh * 256 + dvh * 128, 2048,
                               (bf16*)(ws + WS_OCAT) + 3072 + hh * 256 + dvh * 128, D, 256 * qb, 0, 1, 4, 1 << 20, 0.0625f * 1.44269504089f, shift_mem, flags, tid, lane, wave);
    }
    __syncthreads();
}

__global__ void __launch_bounds__(NWAVES * 64, 2) fwd(Args args) {
    extern __shared__ __attribute__((aligned(16))) unsigned char lds_raw[];
    LAS unsigned char* lds = (LAS unsigned char*)lds_raw;
    const int tid = threadIdx.x, lane = tid & 63, wave = __builtin_amdgcn_readfirstlane(tid >> 6);
    const int G = gridDim.x, bx = blockIdx.x;
    const int vcu = (G % 8 == 0) ? (bx % 8) * (G / 8) + bx / 8 : bx;
    const int gw = vcu * NWAVES + wave, NGW = G * NWAVES;
    unsigned char* ws = args.ws;
    for (int u = tid; u < (LDS_BYTES - LDSCTL_OFF) / 4; u += NWAVES * 64) ((LAS unsigned*)(lds + LDSCTL_OFF))[u] = 0u;
    __syncthreads();
    unsigned* barw = (unsigned*)(ws + WS_CTL) + CW_BAR + args.li * XCD_BAR_WORDS;
    XcdBarrier bar; bar.bar = barw; bar.x = 0; bar.st = nullptr;
    const int lo = args.ph_lo, hi = args.ph_hi;
    if (hi - lo > 1) bar = xcd_barrier_post(barw, (volatile LAS unsigned*)(lds + LDSCTL_OFF + 64));
#define IN(k) (lo <= (k) && (k) < hi)
#define SEAM(k) do { if (IN(k) && IN((k) + 1)) xcd_barrier(bar); } while (0)

    if (IN(0)) { p0_prologue(args, lds, gw, NGW, wave, lane); __syncthreads(); }
    SEAM(0);
    if (IN(1)) {
        { pg8::Gemm g{(const bf16*)(ws + WS_H), (const bf16*)(ws + WS_WIN), S, NP, D}; pg8::StaticOrder So; So.init(S, NP, G, bx);
          pg8::EpiProj E{(bf16*)(ws + WS_PROJ), NP, C_GATE / 256, (float*)(ws + WS_CTL + CTL_SSQ_OFF) + S, (float*)(ws + WS_CTL + CTL_SSQ_OFF) + 2 * S, C_CQ / 128, C_CKV / 128, C_CKV / 128, C_KPE / 128};
          pg8::gemm_phase<pg8::EpiProj, pg8::StaticOrder, true, true>(lds, g, So, E); }
        if (G == 256 && bx >= 128 && bx < 248) p1_deferred_convert(args, lds, (bx - 128) * NWAVES + wave, 120 * NWAVES, wave, lane);
        else if (G != 256) p1_deferred_convert(args, lds, gw, NGW, wave, lane);
        __syncthreads();
        { pg8::Gemm g{(const bf16*)(ws + WS_HM), (const bf16*)(ws + WS_WMEMKV), NMEM, 2048, D}; pg8::StaticOrder So; So.init(NMEM, 2048, G, G - 1 - bx);
          pg8::EpiProj E{(bf16*)(ws + WS_MKV), 2048, 1 << 30, nullptr, nullptr, 0, 0, 0, 0};
          pg8::gemm_phase<pg8::EpiProj, pg8::StaticOrder, true, true>(lds, g, So, E);
          for (int i = 0; ; ++i) { pg8::Unit u; if (!So.next(i, u)) break; if (u.pn < 4) mk_finalize_tile(args, u.pn, wave, lane); } }
    }
    SEAM(1);
    if (IN(3)) {
        const float* ssq = (const float*)(ws + WS_CTL + CTL_SSQ_OFF);
        { pg8::Gemm g{(const bf16*)(ws + WS_PROJ) + C_CKV, (const bf16*)(ws + WS_WKVB), S, NKVB, KVLORA, NP, 0}; pg8::StaticOrder So; So.init(S, NKVB, G, bx);
          pg8::EpiRowScale E{(bf16*)(ws + WS_KVRAW), NKVB, ssq + 2 * S, 1.0f / KVLORA, EPS};
          pg8::gemm_phase<pg8::EpiRowScale, pg8::StaticOrder, true, true>(lds, g, So, E);
          for (int i = 0; ; ++i) { pg8::Unit u; if (!So.next(i, u)) break; k_finalize_tile(args, u.pm, u.pn, wave, lane); } }
        { pg8::Gemm g{(const bf16*)(ws + WS_PROJ) + C_CQ, (const bf16*)(ws + WS_WQB), S, NQB, QLORA, NP, 0}; pg8::StaticOrder So; So.init(S, NQB, G, G - 1 - bx);
          pg8::EpiRowScale E{(bf16*)(ws + WS_QRAW), NQB, ssq + S, 1.0f / QLORA, EPS};
          pg8::gemm_phase<pg8::EpiRowScale, pg8::StaticOrder, true, true>(lds, g, So, E); }
    }
    SEAM(3);
    if (IN(5)) p5_attention(args, lds, tid, lane, wave, 0);
    SEAM(5);
    const bool stag = NGW * 8 == 64 * 256;
    const int sj = (bx >> 3) & 3;
    if (IN(6) && stag && sj > 0) { tr_pipeline<1>(args, lds + wave * 8192, gw, NGW, lane, 0, sj * NGW); __syncthreads(); }
    if (IN(6)) {
        pg8::Gemm g{(const bf16*)(ws + WS_OCAT), (const bf16*)(ws + WS_WCAT), S, D, D}; pg8::StaticOrder So; So.init(S, D, G, bx);
        pg8::EpiMergeSeg E{(const bf16*)(ws + WS_PROJ) + C_GATE, NP, D, (bf16*)(ws + WS_MERGED), D};
        pg8::gemm_phase<pg8::EpiMergeSeg, pg8::StaticOrder, true, true>(lds, g, So, E);
    }
    if (IN(6) && stag && sj < 3) tr_pipeline<1>(args, lds + wave * 8192, gw, NGW, lane, sj * NGW, 3 * NGW);
    SEAM(6);
    if (IN(7)) {
        pg8::Gemm g{(const bf16*)(ws + WS_MERGED), (const bf16*)(ws + WS_WOUT), S, D, D}; pg8::StaticOrder So; So.init(S, D, G, bx);
        pg8::EpiWout E{args.in[0], (bf16*)(ws + WS_X1B), (bf16*)(ws + WS_XG), args.in[19], (float*)(ws + WS_CTL + CTL_SSQ_OFF), D};
        pg8::gemm_phase<pg8::EpiWout, pg8::StaticOrder, true, true>(lds, g, So, E);
    }
    if (IN(7)) tr_pipeline<1>(args, lds + wave * 8192, gw, NGW, lane, stag ? 3 * NGW : 0);
    SEAM(7);
    if (IN(8)) {
        pg8::Gemm g{(const bf16*)(ws + WS_XG), (const bf16*)(ws + WS_WFF1), S, DFF, D}; pg8::StaticOrder So; So.init(S, DFF, G, bx);
        pg8::EpiFF1 E{(bf16*)(ws + WS_U), LDU, (const float*)(ws + WS_CTL + CTL_SSQ_OFF), 1.0f / D, EPS};
        pg8::gemm_phase<pg8::EpiFF1, pg8::StaticOrder, true, true>(lds, g, So, E);
    }
    if (IN(8)) tr_pipeline<2>(args, lds + wave * 8192, gw, NGW, lane);
    SEAM(8);
    if (IN(9)) {
        pg8::Gemm g{(const bf16*)(ws + WS_U), (const bf16*)(ws + WS_WFF2), S, D, DFF, LDU, 0}; pg8::StaticOrder So; So.init(S, D, G, bx, P9_WGM);
        pg8::EpiAccF32 E{args.out, (const bf16*)(ws + WS_X1B), D};
        pg8::gemm_phase<pg8::EpiAccF32, pg8::StaticOrder, true, true>(lds, g, So, E);
    }
#undef IN
#undef SEAM
}

extern "C" void kernel_launch(void* const* d_in, const int* in_sizes, int n_in, void* d_out, int out_size, void* d_ws, size_t ws_size, hipStream_t stream) {
    static int grid = 0;
    if (grid == 0) {
        if (n_in != 22 || in_sizes[0] != S * D || out_size != S * D || ws_size < WS_END) {
            fprintf(stderr, "kernel_launch: unexpected shapes (n_in %d, in0 %d, out %d, ws %zu < %zu); nothing launched\n", n_in, n_in > 0 ? in_sizes[0] : -1, out_size, ws_size, (size_t)WS_END); grid = -1; return; }
        int dev = 0, cus = 0, per_cu = 0;
        if (hipGetDevice(&dev) != hipSuccess || hipDeviceGetAttribute(&cus, hipDeviceAttributeMultiprocessorCount, dev) != hipSuccess) { grid = -1; return; }
        if (hipFuncSetAttribute((const void*)fwd, hipFuncAttributeMaxDynamicSharedMemorySize, LDS_BYTES) != hipSuccess) { fprintf(stderr, "kernel_launch: hipFuncSetAttribute failed\n"); grid = -1; return; }
        if (hipOccupancyMaxActiveBlocksPerMultiprocessor(&per_cu, (const void*)fwd, NWAVES * 64, LDS_BYTES) != hipSuccess || per_cu < 1)
            fprintf(stderr, "kernel_launch: note: occupancy query reports %d workgroups per CU\n", per_cu);
        (void)hipGetLastError();
        grid = cus;
    }
    if (grid < 0) return;
    if (hipMemsetAsync((char*)d_ws + WS_CTL, 0, CTL_ZERO_BYTES, stream) != hipSuccess) { fprintf(stderr, "kernel_launch: memset failed\n"); return; }
    Args a{};
    for (int i = 0; i < 22; ++i) a.in[i] = (const float*)d_in[i];
    a.out = (float*)d_out; a.ws = (unsigned char*)d_ws;
    for (int li = 0; li < NLAUNCH; ++li) {
        a.ph_lo = (NLAUNCH == 1) ? 0 : li; a.ph_hi = (NLAUNCH == 1) ? NPH : li + 1; a.li = (NLAUNCH == 1) ? 0 : 0; a.pad = 0;
        hipLaunchKernelGGL(fwd, dim3(grid), dim3(NWAVES * 64), LDS_BYTES, stream, a);
        const hipError_t le = hipPeekAtLastError();
        if (le != hipSuccess) { fprintf(stderr, "kernel_launch: launch %d failed: %s\n", li, hipGetErrorName(le)); break; }
    }
}
```

```cpp
#include <hip/hip_runtime.h>
#include <cstdio>
#include <cstdint>
namespace pg8 {
#define PG8_LAS __attribute__((address_space(3)))
typedef unsigned short bf16_t;
typedef short bf16x8 __attribute__((ext_vector_type(8)));
typedef float f32x4 __attribute__((ext_vector_type(4)));
typedef unsigned u32x4 __attribute__((ext_vector_type(4)));
constexpr int BM = 256, BK = 64, HALF = 128, HTB = HALF * BK * 2  , STAGE_BYTES = 8 * HTB, NXCD = 8, WGM = 8;

__host__ __device__ __forceinline__ int lds_byte(int r, int c) { const int st = (r >> 4) * 2 + (c >> 5), rr = r & 15, cc = c & 31, ob = rr * 64 + cc * 2; return st * 1024 + (ob ^ (((ob >> 9) & 1) << 5)); }
__host__ __device__ __forceinline__ void stage_rc(int b, int& R, int& C) { const int st = b / 1024, sb = b % 1024, swz = sb ^ (((sb >> 9) & 1) << 5); R = (st >> 1) * 16 + swz / 64; C = (st & 1) * 32 + (swz % 64) / 2; }
__host__ __device__ __forceinline__ int perm32(int rho) { const int n = rho >> 4, i = rho & 15; return 8 * (i >> 2) + 4 * n + (i & 3); }

struct Unit { int pm, pn; };
struct Gemm { const bf16_t* A; const bf16_t* Bt; int M, N, K; int lda = 0, ldb = 0; };

struct StaticOrder {
    int nM, nN, nwg, G, c, wgm;
    __host__ __device__ void init(int M, int N, int G_, int c_, int wgm_ = WGM) { nM = M / BM; nN = N / BM; nwg = nM * nN; G = G_; c = c_; wgm = wgm_; }
    __host__ __device__ bool next(int i, Unit& u) const {
        const long L = (long)i * G + c; if (L >= nwg) return false;
        int wgid = (int)L; { const int q = nwg / NXCD, r = nwg % NXCD, xcd = wgid % NXCD, off = wgid / NXCD; wgid = (xcd < r ? xcd * (q + 1) : r * (q + 1) + (xcd - r) * q) + off; }
        const int nig = wgm * nN, gid = wgid / nig, fm = gid * wgm, gsz = (nM - fm) < wgm ? (nM - fm) : wgm;
        u.pm = fm + ((wgid % nig) % gsz); u.pn = (wgid % nig) / gsz; return true;
    }
    __device__ __forceinline__ void a_ready(const Unit&) const {}
    __device__ __forceinline__ void done(const Unit&) const {}
};

__device__ __forceinline__ unsigned cvt_pk_bf16(float lo, float hi) { unsigned r; asm volatile("v_cvt_pk_bf16_f32 %0, %1, %2" : "=v"(r) : "v"(lo), "v"(hi)); return r; }
__device__ __forceinline__ float bflo(unsigned w) { return __builtin_bit_cast(float, w << 16); }
__device__ __forceinline__ float bfhi(unsigned w) { return __builtin_bit_cast(float, w & 0xffff0000u); }
__device__ __forceinline__ float sigm(float v) { return __builtin_amdgcn_rcpf(1.0f + __builtin_amdgcn_exp2f(v * -1.44269504089f)); }

struct EpiProj {
    static constexpr bool PERM = true, AFTER_DRAIN = false; static constexpr int NSEG = 1, SEG1 = -1, SEG2 = -1;
    bf16_t* O; int ldc; int sig_pn;
    float* ssq_a; float* ssq_b; int ha0, ha1, hb0, hb1;
    __device__ __forceinline__ void operator()(const f32x4 (&acc)[2][2][4][2], const Unit& u, int wr, int wc, int fr, int fq) const {
        const int row0 = u.pm * BM + wr * 64 + fr, col0 = u.pn * BM + wc * 32 + 8 * fq;
        const bool sg = u.pn >= sig_pn;
        const bool st = ssq_a != nullptr && 2 * u.pn + 1 >= ha0 && 2 * u.pn < hb1;
#pragma unroll
        for (int ai = 0; ai < 2; ++ai)
#pragma unroll
            for (int m = 0; m < 4; ++m) { const int row = row0 + ai * HALF + m * 16; bf16_t* rowp = O + (size_t)row * ldc + col0;
#pragma unroll
                for (int bj = 0; bj < 2; ++bj) { f32x4 v0 = acc[ai][bj][m][0], v1 = acc[ai][bj][m][1];
                    if (sg) {
#pragma unroll
                        for (int j = 0; j < 4; ++j) { v0[j] = sigm(v0[j]); v1[j] = sigm(v1[j]); } }
                    if (st) { const int hi = 2 * u.pn + bj;
                        float ss = (v0[0] * v0[0] + v0[1] * v0[1]) + (v0[2] * v0[2] + v0[3] * v0[3]) + (v1[0] * v1[0] + v1[1] * v1[1]) + (v1[2] * v1[2] + v1[3] * v1[3]);
                        ss += __shfl_xor(ss, 16); ss += __shfl_xor(ss, 32);
                        if (fq == 0) { if (hi >= ha0 && hi < ha1) atomicAdd(ssq_a + row, ss); else if (hi >= hb0 && hi < hb1) atomicAdd(ssq_b + row, ss); } }
                    u32x4 w; w.x = cvt_pk_bf16(v0[0], v0[1]); w.y = cvt_pk_bf16(v0[2], v0[3]); w.z = cvt_pk_bf16(v1[0], v1[1]); w.w = cvt_pk_bf16(v1[2], v1[3]);
                    *(u32x4*)(rowp + bj * HALF) = w; } }
    }
};

struct EpiRowScale {
    static constexpr bool PERM = true, AFTER_DRAIN = false; static constexpr int NSEG = 1, SEG1 = -1, SEG2 = -1;
    bf16_t* O; int ldc; const float* ssq; float inv_n, eps;
    __device__ __forceinline__ void operator()(const f32x4 (&acc)[2][2][4][2], const Unit& u, int wr, int wc, int fr, int fq) const {
        const int row0 = u.pm * BM + wr * 64 + fr, col0 = u.pn * BM + wc * 32 + 8 * fq;
        float sq[2][4];
#pragma unroll
        for (int ai = 0; ai < 2; ++ai)
#pragma unroll
            for (int m = 0; m < 4; ++m) sq[ai][m] = ssq[row0 + ai * HALF + m * 16];
        __builtin_amdgcn_sched_barrier(0);
#pragma unroll
        for (int ai = 0; ai < 2; ++ai)
#pragma unroll
            for (int m = 0; m < 4; ++m) { const size_t row = (size_t)(row0 + ai * HALF + m * 16);
                const float rs = 1.0f / __builtin_sqrtf(sq[ai][m] * inv_n + eps);
                bf16_t* rowp = O + row * ldc + col0;
#pragma unroll
                for (int bj = 0; bj < 2; ++bj) { const f32x4 v0 = acc[ai][bj][m][0] * rs, v1 = acc[ai][bj][m][1] * rs;
                    u32x4 w; w.x = cvt_pk_bf16(v0[0], v0[1]); w.y = cvt_pk_bf16(v0[2], v0[3]); w.z = cvt_pk_bf16(v1[0], v1[1]); w.w = cvt_pk_bf16(v1[2], v1[3]);
                    *(u32x4*)(rowp + bj * HALF) = w; } }
    }
};

template <int MODE> struct EpiMerge {
    static constexpr bool PERM = true, AFTER_DRAIN = false; static constexpr int NSEG = 1, SEG1 = -1, SEG2 = -1;
    const bf16_t* G; int ldg; float* P; bf16_t* O; int ldp;
    __device__ __forceinline__ void operator()(const f32x4 (&acc)[2][2][4][2], const Unit& u, int wr, int wc, int fr, int fq) const {
        const int row0 = u.pm * BM + wr * 64 + fr, col0 = u.pn * BM + wc * 32 + 8 * fq;
#pragma unroll
        for (int ai = 0; ai < 2; ++ai)
#pragma unroll
            for (int m = 0; m < 4; ++m) { const size_t row = (size_t)(row0 + ai * HALF + m * 16);
#pragma unroll
                for (int bj = 0; bj < 2; ++bj) { const int col = col0 + bj * HALF;
                    const u32x4 g = *(const u32x4*)(G + row * ldg + col);
                    f32x4 v0 = acc[ai][bj][m][0], v1 = acc[ai][bj][m][1];
                    v0[0] *= bflo(g.x); v0[1] *= bfhi(g.x); v0[2] *= bflo(g.y); v0[3] *= bfhi(g.y);
                    v1[0] *= bflo(g.z); v1[1] *= bfhi(g.z); v1[2] *= bflo(g.w); v1[3] *= bfhi(g.w);
                    float* pp = P + row * ldp + col;
                    if (MODE > 0) { v0 += *(const f32x4*)pp; v1 += *(const f32x4*)(pp + 4); }
                    if (MODE < 2) { *(f32x4*)pp = v0; *(f32x4*)(pp + 4) = v1; }
                    else { u32x4 w; w.x = cvt_pk_bf16(v0[0], v0[1]); w.y = cvt_pk_bf16(v0[2], v0[3]); w.z = cvt_pk_bf16(v1[0], v1[1]); w.w = cvt_pk_bf16(v1[2], v1[3]);
                        *(u32x4*)(O + row * ldp + col) = w; } } }
    }
};

struct EpiMergeSeg {
    static constexpr bool PERM = true, AFTER_DRAIN = false; static constexpr int NSEG = 3, SEG1 = 24, SEG2 = 48;
    const bf16_t* G; int ldg; int gstride; bf16_t* O; int ldo;
    __device__ __forceinline__ void mid(f32x4 (&acc)[2][2][4][2], const Unit& u, int t, int wr, int wc, int fr, int fq) const {
        asm volatile("" : "+v"(fr), "+v"(fq));
        const int row0 = u.pm * BM + wr * 64 + fr, col0 = u.pn * BM + wc * 32 + 8 * fq;
        const bf16_t* gp = G + (t == SEG1 ? 0 : gstride); const bf16_t* gn = gp + gstride;
#pragma unroll
        for (int ai = 0; ai < 2; ++ai)
#pragma unroll
            for (int mh = 0; mh < 2; ++mh) { u32x4 ga[2][2], gb[2][2];
#pragma unroll
                for (int mm = 0; mm < 2; ++mm)
#pragma unroll
                    for (int bj = 0; bj < 2; ++bj) { const size_t o = (size_t)(row0 + ai * HALF + (2 * mh + mm) * 16) * ldg + col0 + bj * HALF; ga[mm][bj] = *(const u32x4*)(gp + o); gb[mm][bj] = *(const u32x4*)(gn + o); }
                __builtin_amdgcn_sched_barrier(0);
#pragma unroll
                for (int mm = 0; mm < 2; ++mm)
#pragma unroll
                    for (int bj = 0; bj < 2; ++bj) { const int m = 2 * mh + mm; const u32x4 a = ga[mm][bj], b = gb[mm][bj];
                        float pa[8] = {bflo(a.x), bfhi(a.x), bflo(a.y), bfhi(a.y), bflo(a.z), bfhi(a.z), bflo(a.w), bfhi(a.w)};
                        float pb[8] = {bflo(b.x), bfhi(b.x), bflo(b.y), bfhi(b.y), bflo(b.z), bfhi(b.z), bflo(b.w), bfhi(b.w)};
#pragma unroll
                        for (int j = 0; j < 8; ++j) { const float r = __builtin_fmaxf(pa[j], 1e-20f) * __builtin_amdgcn_rcpf(__builtin_fmaxf(pb[j], 1e-20f));
                            if (j < 4) acc[ai][bj][m][0][j] *= r; else acc[ai][bj][m][1][j - 4] *= r; } }
                __builtin_amdgcn_sched_barrier(0); }
    }
    __device__ __forceinline__ void operator()(const f32x4 (&acc)[2][2][4][2], const Unit& u, int wr, int wc, int fr, int fq) const {
        asm volatile("" : "+v"(fr), "+v"(fq));
        const int row0 = u.pm * BM + wr * 64 + fr, col0 = u.pn * BM + wc * 32 + 8 * fq;
        const bf16_t* g2 = G + 2 * gstride;
#pragma unroll
        for (int ai = 0; ai < 2; ++ai)
#pragma unroll
            for (int mh = 0; mh < 2; ++mh) { u32x4 gg[2][2];
#pragma unroll
                for (int mm = 0; mm < 2; ++mm)
#pragma unroll
                    for (int bj = 0; bj < 2; ++bj) gg[mm][bj] = *(const u32x4*)(g2 + (size_t)(row0 + ai * HALF + (2 * mh + mm) * 16) * ldg + col0 + bj * HALF);
                __builtin_amdgcn_sched_barrier(0);
#pragma unroll
                for (int mm = 0; mm < 2; ++mm)
#pragma unroll
                    for (int bj = 0; bj < 2; ++bj) { const int m = 2 * mh + mm; const u32x4 g = gg[mm][bj];
                        f32x4 v0 = acc[ai][bj][m][0], v1 = acc[ai][bj][m][1];
                        v0[0] *= __builtin_fmaxf(bflo(g.x), 1e-20f); v0[1] *= __builtin_fmaxf(bfhi(g.x), 1e-20f); v0[2] *= __builtin_fmaxf(bflo(g.y), 1e-20f); v0[3] *= __builtin_fmaxf(bfhi(g.y), 1e-20f);
                        v1[0] *= __builtin_fmaxf(bflo(g.z), 1e-20f); v1[1] *= __builtin_fmaxf(bfhi(g.z), 1e-20f); v1[2] *= __builtin_fmaxf(bflo(g.w), 1e-20f); v1[3] *= __builtin_fmaxf(bfhi(g.w), 1e-20f);
                        u32x4 w; w.x = cvt_pk_bf16(v0[0], v0[1]); w.y = cvt_pk_bf16(v0[2], v0[3]); w.z = cvt_pk_bf16(v1[0], v1[1]); w.w = cvt_pk_bf16(v1[2], v1[3]);
                        *(u32x4*)(O + (size_t)(row0 + ai * HALF + m * 16) * ldo + col0 + bj * HALF) = w; }
                __builtin_amdgcn_sched_barrier(0); }
    }
};

struct EpiWout {
    static constexpr bool PERM = true, AFTER_DRAIN = false; static constexpr int NSEG = 1, SEG1 = -1, SEG2 = -1;
    const float* X; bf16_t* X1B; bf16_t* XG; const float* gf; float* ssq; int ld;
    __device__ __forceinline__ void operator()(const f32x4 (&acc)[2][2][4][2], const Unit& u, int wr, int wc, int fr, int fq) const {
        const int row0 = u.pm * BM + wr * 64 + fr, col0 = u.pn * BM + wc * 32 + 8 * fq;
        f32x4 gv[2][2];
#pragma unroll
        for (int bj = 0; bj < 2; ++bj)
#pragma unroll
            for (int n = 0; n < 2; ++n) gv[bj][n] = *(const f32x4*)(gf + col0 + bj * HALF + 4 * n);
#pragma unroll
        for (int ai = 0; ai < 2; ++ai)
#pragma unroll
            for (int mh = 0; mh < 2; ++mh) { f32x4 xa[2][2][2];
#pragma unroll
                for (int mm = 0; mm < 2; ++mm)
#pragma unroll
                    for (int bj = 0; bj < 2; ++bj) { const size_t o = (size_t)(row0 + ai * HALF + (2 * mh + mm) * 16) * ld + col0 + bj * HALF; xa[mm][bj][0] = *(const f32x4*)(X + o); xa[mm][bj][1] = *(const f32x4*)(X + o + 4); }
                __builtin_amdgcn_sched_barrier(0);
#pragma unroll
                for (int mm = 0; mm < 2; ++mm) { const int m = 2 * mh + mm; const size_t row = (size_t)(row0 + ai * HALF + m * 16); float ss = 0.f;
#pragma unroll
                    for (int bj = 0; bj < 2; ++bj) { const size_t o = row * ld + col0 + bj * HALF;
                        const f32x4 v0 = acc[ai][bj][m][0] + xa[mm][bj][0], v1 = acc[ai][bj][m][1] + xa[mm][bj][1];
                        u32x4 xw; xw.x = cvt_pk_bf16(v0[0], v0[1]); xw.y = cvt_pk_bf16(v0[2], v0[3]); xw.z = cvt_pk_bf16(v1[0], v1[1]); xw.w = cvt_pk_bf16(v1[2], v1[3]);
                        *(u32x4*)(X1B + o) = xw;
                        ss += (v0[0] * v0[0] + v0[1] * v0[1]) + (v0[2] * v0[2] + v0[3] * v0[3]) + (v1[0] * v1[0] + v1[1] * v1[1]) + (v1[2] * v1[2] + v1[3] * v1[3]);
                        const f32x4 a = v0 * gv[bj][0], b = v1 * gv[bj][1];
                        u32x4 w; w.x = cvt_pk_bf16(a[0], a[1]); w.y = cvt_pk_bf16(a[2], a[3]); w.z = cvt_pk_bf16(b[0], b[1]); w.w = cvt_pk_bf16(b[2], b[3]);
                        *(u32x4*)(XG + o) = w; }
                    ss += __shfl_xor(ss, 16); ss += __shfl_xor(ss, 32);
                    if (fq == 0) atomicAdd(ssq + row, ss); }
                __builtin_amdgcn_sched_barrier(0); }
    }
};

struct EpiFF1 {
    static constexpr bool PERM = true, AFTER_DRAIN = false; static constexpr int NSEG = 1, SEG1 = -1, SEG2 = -1;
    bf16_t* U; int ldc; const float* ssq; float inv_n, eps;
    __device__ __forceinline__ void operator()(const f32x4 (&acc)[2][2][4][2], const Unit& u, int wr, int wc, int fr, int fq) const {
        const int row0 = u.pm * BM + wr * 64 + fr, col0 = u.pn * BM + wc * 32 + 8 * fq;
        float sq[2][4];
#pragma unroll
        for (int ai = 0; ai < 2; ++ai)
#pragma unroll
            for (int m = 0; m < 4; ++m) sq[ai][m] = ssq[row0 + ai * HALF + m * 16];
        __builtin_amdgcn_sched_barrier(0);
#pragma unroll
        for (int ai = 0; ai < 2; ++ai)
#pragma unroll
            for (int m = 0; m < 4; ++m) { const size_t row = (size_t)(row0 + ai * HALF + m * 16);
                const float rs = 1.0f / __builtin_sqrtf(sq[ai][m] * inv_n + eps);
                bf16_t* rowp = U + row * ldc + col0;
#pragma unroll
                for (int bj = 0; bj < 2; ++bj) { f32x4 v0 = acc[ai][bj][m][0] * rs, v1 = acc[ai][bj][m][1] * rs;
#pragma unroll
                    for (int j = 0; j < 4; ++j) { const float a = __builtin_fmaxf(v0[j], 0.f), b = __builtin_fmaxf(v1[j], 0.f); v0[j] = a * a; v1[j] = b * b; }
                    u32x4 w; w.x = cvt_pk_bf16(v0[0], v0[1]); w.y = cvt_pk_bf16(v0[2], v0[3]); w.z = cvt_pk_bf16(v1[0], v1[1]); w.w = cvt_pk_bf16(v1[2], v1[3]);
                    *(u32x4*)(rowp + bj * HALF) = w; } }
    }
};

struct EpiAccF32 {
    static constexpr bool PERM = true, AFTER_DRAIN = false; static constexpr int NSEG = 1, SEG1 = -1, SEG2 = -1;
    float* C; const bf16_t* X1B; int ldc;
    __device__ __forceinline__ void operator()(const f32x4 (&acc)[2][2][4][2], const Unit& u, int wr, int wc, int fr, int fq) const {
        const int row0 = u.pm * BM + wr * 64 + fr, col0 = u.pn * BM + wc * 32 + 8 * fq;
#pragma unroll
        for (int ai = 0; ai < 2; ++ai) { u32x4 xw[4][2];
#pragma unroll
            for (int m = 0; m < 4; ++m)
#pragma unroll
                for (int bj = 0; bj < 2; ++bj) xw[m][bj] = *(const u32x4*)(X1B + (size_t)(row0 + ai * HALF + m * 16) * ldc + col0 + bj * HALF);
            __builtin_amdgcn_sched_barrier(0);
#pragma unroll
            for (int m = 0; m < 4; ++m) { const size_t ro = (size_t)(row0 + ai * HALF + m * 16) * ldc + col0;
#pragma unroll
                for (int bj = 0; bj < 2; ++bj) { const u32x4 x = xw[m][bj];
                    f32x4 v0 = acc[ai][bj][m][0], v1 = acc[ai][bj][m][1];
                    v0[0] += bflo(x.x); v0[1] += bfhi(x.x); v0[2] += bflo(x.y); v0[3] += bfhi(x.y); v1[0] += bflo(x.z); v1[1] += bfhi(x.z); v1[2] += bflo(x.w); v1[3] += bfhi(x.w);
                    float* p = C + ro + bj * HALF; *(f32x4*)p = v0; *(f32x4*)(p + 4) = v1; } }
            __builtin_amdgcn_sched_barrier(0); }
    }
};

template <class Epi, class Sched, bool ALIGN_EPI = false, bool SP2 = false>
__device__ __forceinline__ void gemm_phase(PG8_LAS unsigned char* lds, const Gemm g, const Sched& S, const Epi& E) {
    const int tid = threadIdx.x, wid = __builtin_amdgcn_readfirstlane(tid >> 6), lane = tid & 63, wr = wid >> 2, wc = wid & 3, fr = lane & 15, fq = lane >> 4;
    const int K = g.K, nt = K / BK, lda = g.lda ? g.lda : K, ldb = g.ldb ? g.ldb : K;
    unsigned voffA[2], voffB[2];
#pragma unroll
    for (int i = 0; i < 2; ++i) { int R, C; stage_rc(tid * 16 + i * 8192, R, C); const int Rb = Epi::PERM ? ((R & ~31) + perm32(R & 31)) : R;
        voffA[i] = (unsigned)(R * lda + C) * 2u; voffB[i] = (unsigned)(Rb * ldb + C) * 2u; }
    const size_t kstep = (size_t)(BK * 2);
    const size_t hstepA = (size_t)HALF * lda * 2, hstepB = (size_t)HALF * ldb * 2;
    const size_t tstepA = 2 * hstepA, tstepB = 2 * hstepB;
    const unsigned ldsw = (unsigned)wid * 1024u;
    const int aoff = lds_byte(wr * 64 + fr, fq * 8), boff = lds_byte(wc * 32 + fr, fq * 8);
#define PG8_SA(b, h) (((b) * 2 + (h)) * HTB)
#define PG8_SB(b, h) ((4 + (b) * 2 + (h)) * HTB)
#define PG8_STAGE(bufoff, gbase, voff) do { _Pragma("unroll") for (int _i = 0; _i < 2; ++_i) \
        __builtin_amdgcn_global_load_lds((const unsigned*)((const char*)(gbase) + (voff)[_i]), (PG8_LAS unsigned*)(lds + (bufoff) + ldsw + _i * 8192), 16, 0, 0); } while (0)
#define PG8_LDA(dst, b, h) do { _Pragma("unroll") for (int m = 0; m < 4; ++m) _Pragma("unroll") for (int k = 0; k < 2; ++k) dst[m][k] = *(const PG8_LAS bf16x8*)(lds + PG8_SA(b, h) + aoff + m * 2048 + k * 1024); } while (0)
#define PG8_LDB(dst, b, h) do { _Pragma("unroll") for (int n = 0; n < 2; ++n) _Pragma("unroll") for (int k = 0; k < 2; ++k) dst[n][k] = *(const PG8_LAS bf16x8*)(lds + PG8_SB(b, h) + boff + n * 2048 + k * 1024); } while (0)
#define PG8_MMA(ai, bj, At, Bt) do { __builtin_amdgcn_s_setprio(1); _Pragma("unroll") for (int m = 0; m < 4; ++m) _Pragma("unroll") for (int n = 0; n < 2; ++n) _Pragma("unroll") for (int k = 0; k < 2; ++k) \
        acc[ai][bj][m][n] = __builtin_amdgcn_mfma_f32_16x16x32_bf16(Bt[n][k], At[m][k], acc[ai][bj][m][n], 0, 0, 0); __builtin_amdgcn_s_setprio(0); } while (0)
#define PG8_WAIT_V(n) asm volatile("s_waitcnt vmcnt(" #n ")" ::: "memory")
#define PG8_WAIT_L(n) asm volatile("s_waitcnt lgkmcnt(" #n ")" ::: "memory")
#define PG8_BAR __builtin_amdgcn_s_barrier()
#define PG8_SCHED __builtin_amdgcn_sched_barrier(0)
    Unit cur, nxt; int ui = 0;
    if (!S.next(0, cur)) return;
    f32x4 acc[2][2][4][2];
#pragma unroll
    for (int a = 0; a < 2; ++a)
#pragma unroll
        for (int b = 0; b < 2; ++b)
#pragma unroll
            for (int m = 0; m < 4; ++m)
#pragma unroll
                for (int n = 0; n < 2; ++n) acc[a][b][m][n] = (f32x4){0.f, 0.f, 0.f, 0.f};
    bf16x8 At[4][2], B0[2][2], B1[2][2];
    const char* cA = (const char*)g.A + (size_t)cur.pm * tstepA; const char* cB = (const char*)g.Bt + (size_t)cur.pn * tstepB;
    S.a_ready(cur);
    if constexpr (SP2) {
        PG8_STAGE(PG8_SB(0, 0), cB, voffB); PG8_STAGE(PG8_SB(0, 1), cB + hstepB, voffB); PG8_STAGE(PG8_SA(0, 0), cA, voffA); PG8_STAGE(PG8_SA(0, 1), cA + hstepA, voffA);
        if (wr == 1) PG8_BAR;
        PG8_WAIT_V(2); PG8_BAR;
        PG8_STAGE(PG8_SB(1, 0), cB + kstep, voffB); PG8_STAGE(PG8_SA(1, 0), cA + kstep, voffA); PG8_STAGE(PG8_SB(1, 1), cB + hstepB + kstep, voffB);
        PG8_WAIT_V(6); PG8_BAR;
    } else {
        PG8_STAGE(PG8_SB(0, 0), cB, voffB); PG8_STAGE(PG8_SA(0, 0), cA, voffA); PG8_STAGE(PG8_SB(0, 1), cB + hstepB, voffB); PG8_STAGE(PG8_SA(0, 1), cA + hstepA, voffA);
        if (wr == 1) PG8_BAR;
        PG8_WAIT_V(4); PG8_BAR;
        PG8_STAGE(PG8_SB(1, 0), cB + kstep, voffB); PG8_STAGE(PG8_SA(1, 0), cA + kstep, voffA); PG8_STAGE(PG8_SB(1, 1), cB + hstepB + kstep, voffB);
        PG8_WAIT_V(6); PG8_BAR;
    }
    for (;;) {
        const bool has_next = S.next(ui + 1, nxt);
        const char* nA = has_next ? (const char*)g.A + (size_t)nxt.pm * tstepA : cA; const char* nB = has_next ? (const char*)g.Bt + (size_t)nxt.pn * tstepB : cB;
        int tb_ = 0;
#pragma nounroll
        for (int seg_ = 0; seg_ < Epi::NSEG; ++seg_) {
        const int te_ = (Epi::NSEG == 1) ? nt : (seg_ == 0 ? Epi::SEG1 : (seg_ == 1 ? Epi::SEG2 : nt));
        for (int t = tb_; t < te_; t += 2) {
            const bool last = (t == nt - 2);
            const char* a1 = cA + (size_t)(t + 1) * kstep;
            const char* a2 = last ? nA : cA + (size_t)(t + 2) * kstep; const char* b2 = last ? nB : cB + (size_t)(t + 2) * kstep;
            const char* a3 = a2 + kstep; const char* b3 = b2 + kstep;
            if (last && has_next) S.a_ready(nxt);
            if constexpr (SP2) {
            PG8_LDB(B0, 0, 0); PG8_LDB(B1, 0, 1); PG8_SCHED; PG8_LDA(At, 0, 0); PG8_STAGE(PG8_SA(1, 1), a1 + hstepA, voffA);
            PG8_WAIT_V(8); PG8_WAIT_L(0); PG8_BAR; PG8_MMA(0, 0, At, B0); PG8_MMA(0, 1, At, B1); PG8_BAR; PG8_SCHED;
            PG8_LDA(At, 0, 1); PG8_STAGE(PG8_SB(0, 0), b2, voffB); PG8_STAGE(PG8_SB(0, 1), b2 + hstepB, voffB); PG8_STAGE(PG8_SA(0, 0), a2, voffA);
            PG8_WAIT_V(8); PG8_WAIT_L(0); PG8_BAR; PG8_MMA(1, 0, At, B0); PG8_MMA(1, 1, At, B1); PG8_BAR; PG8_SCHED;
            PG8_LDB(B0, 1, 0); PG8_LDB(B1, 1, 1); PG8_SCHED; PG8_LDA(At, 1, 0); PG8_STAGE(PG8_SA(0, 1), a2 + hstepA, voffA);
            PG8_WAIT_V(8); PG8_WAIT_L(0); PG8_BAR; PG8_MMA(0, 0, At, B0); PG8_MMA(0, 1, At, B1); PG8_BAR; PG8_SCHED;
            PG8_LDA(At, 1, 1); PG8_STAGE(PG8_SB(1, 0), b3, voffB); PG8_STAGE(PG8_SB(1, 1), b3 + hstepB, voffB); PG8_STAGE(PG8_SA(1, 0), a3, voffA);
            PG8_WAIT_V(8); PG8_WAIT_L(0); PG8_BAR; PG8_MMA(1, 0, At, B0); PG8_MMA(1, 1, At, B1); PG8_BAR; PG8_SCHED;
            } else {
            PG8_LDB(B0, 0, 0); PG8_SCHED; PG8_LDA(At, 0, 0); PG8_STAGE(PG8_SA(1, 1), a1 + hstepA, voffA);
            PG8_WAIT_L(8); PG8_BAR; PG8_WAIT_L(0); PG8_MMA(0, 0, At, B0); PG8_BAR; PG8_SCHED;
            PG8_LDB(B1, 0, 1); PG8_STAGE(PG8_SB(0, 0), b2, voffB);
            PG8_BAR; PG8_WAIT_L(0); PG8_MMA(0, 1, At, B1); PG8_BAR;
            PG8_LDA(At, 0, 1); PG8_STAGE(PG8_SA(0, 0), a2, voffA);
            PG8_BAR; PG8_WAIT_L(0); PG8_MMA(1, 0, At, B0); PG8_BAR; PG8_SCHED;
            PG8_STAGE(PG8_SB(0, 1), b2 + hstepB, voffB);
            PG8_WAIT_V(6); PG8_BAR; PG8_MMA(1, 1, At, B1); PG8_BAR;
            PG8_LDB(B0, 1, 0); PG8_SCHED; PG8_LDA(At, 1, 0); PG8_STAGE(PG8_SA(0, 1), a2 + hstepA, voffA);
            PG8_WAIT_L(8); PG8_BAR; PG8_WAIT_L(0); PG8_MMA(0, 0, At, B0); PG8_BAR; PG8_SCHED;
            PG8_LDB(B1, 1, 1); PG8_STAGE(PG8_SB(1, 0), b3, voffB);
            PG8_BAR; PG8_WAIT_L(0); PG8_MMA(0, 1, At, B1); PG8_BAR;
            PG8_LDA(At, 1, 1); PG8_STAGE(PG8_SA(1, 0), a3, voffA);
            PG8_BAR; PG8_WAIT_L(0); PG8_MMA(1, 0, At, B0); PG8_BAR; PG8_SCHED;
            PG8_STAGE(PG8_SB(1, 1), b3 + hstepB, voffB);
            PG8_WAIT_V(6); PG8_BAR; PG8_MMA(1, 1, At, B1); PG8_BAR;
            }
        }
        if constexpr (Epi::NSEG > 1) { if (seg_ + 1 < Epi::NSEG) E.mid(acc, cur, te_, wr, wc, fr, fq); }
        tb_ = te_;
        }
        if constexpr (ALIGN_EPI) { if (wr == 0) PG8_BAR; }
        if constexpr (!Epi::AFTER_DRAIN) { E(acc, cur, wr, wc, fr, fq); S.done(cur); }
        if (!has_next) break;
#pragma unroll
        for (int a = 0; a < 2; ++a)
#pragma unroll
            for (int b = 0; b < 2; ++b)
#pragma unroll
                for (int m = 0; m < 4; ++m)
#pragma unroll
                    for (int n = 0; n < 2; ++n) acc[a][b][m][n] = (f32x4){0.f, 0.f, 0.f, 0.f};
        cur = nxt; cA = nA; cB = nB; ++ui;
        if constexpr (ALIGN_EPI) { if (wr == 1) PG8_BAR; }
    }
    PG8_WAIT_V(0);
    if constexpr (!ALIGN_EPI) { if (wr == 0) PG8_BAR; }
    PG8_BAR;
    if constexpr (Epi::AFTER_DRAIN) { E.fused(acc, cur, wr, wc, fr, fq, lds, wid, lane); S.done(cur); }
#undef PG8_SA
#undef PG8_SB
#undef PG8_STAGE
#undef PG8_LDA
#undef PG8_LDB
#undef PG8_MMA
#undef PG8_WAIT_V
#undef PG8_WAIT_L
#undef PG8_BAR
#undef PG8_SCHED
}
}

namespace att {
typedef short bf16x8 __attribute__((ext_vector_type(8)));
typedef short s16x4 __attribute__((ext_vector_type(4)));
typedef float f32x16 __attribute__((ext_vector_type(16)));
typedef unsigned u32x4 __attribute__((ext_vector_type(4)));
typedef unsigned u32x2 __attribute__((ext_vector_type(2)));
typedef float f32x4 __attribute__((ext_vector_type(4)));
#define ATT_LAS __attribute__((address_space(3)))
constexpr int KBUF = 32768, VBUF = 16384, STAGE = KBUF + VBUF;

__device__ __forceinline__ bf16x8 pack_step(const f32x16& x, int s) {
    u32x4 p;
    asm volatile("v_cvt_pk_bf16_f32 %0, %4, %5\n\tv_cvt_pk_bf16_f32 %1, %6, %7\n\tv_cvt_pk_bf16_f32 %2, %8, %9\n\tv_cvt_pk_bf16_f32 %3, %10, %11\n\ts_nop 1"
                 : "=&v"(p[0]), "=&v"(p[1]), "=&v"(p[2]), "=&v"(p[3])
                 : "v"(x[8 * s]), "v"(x[8 * s + 1]), "v"(x[8 * s + 2]), "v"(x[8 * s + 3]), "v"(x[8 * s + 4]), "v"(x[8 * s + 5]), "v"(x[8 * s + 6]), "v"(x[8 * s + 7]));
    return __builtin_bit_cast(bf16x8, p);
}
template <int OFF> __device__ __forceinline__ s16x4 tr_read(unsigned addr) {
    s16x4 r; asm volatile("ds_read_b64_tr_b16 %0, %1 offset:%2" : "=&v"(r) : "v"(addr), "i"(OFF) : "memory"); return r;
}
#define ATT_MFMA(a, b, c) __builtin_amdgcn_mfma_f32_32x32x16_bf16((a), (b), (c), 0, 0, 0)

template <int NKS, bool ROPE>
__device__ __forceinline__ void load_q_norm(bf16x8 (&qf)[NKS], const unsigned short* qrow, int h, const float* rc_row, const float* gain, float inv_n, float eps, float qscale = 1.0f) {
    float qv[NKS][8];
#pragma unroll
    for (int ks = 0; ks < NKS; ++ks) { const u32x4 w = *(const u32x4*)(qrow + 16 * ks + 8 * h);
        qv[ks][0] = __builtin_bit_cast(float, w.x << 16); qv[ks][1] = __builtin_bit_cast(float, w.x & 0xffff0000u); qv[ks][2] = __builtin_bit_cast(float, w.y << 16); qv[ks][3] = __builtin_bit_cast(float, w.y & 0xffff0000u);
        qv[ks][4] = __builtin_bit_cast(float, w.z << 16); qv[ks][5] = __builtin_bit_cast(float, w.z & 0xffff0000u); qv[ks][6] = __builtin_bit_cast(float, w.w << 16); qv[ks][7] = __builtin_bit_cast(float, w.w & 0xffff0000u); }
    if (ROPE) {
#pragma unroll
        for (int kk = 0; kk < 2; ++kk) { const float* cp = rc_row + 16 * kk + 8 * h;
            const f32x4 c0 = *(const f32x4*)cp, c1 = *(const f32x4*)(cp + 4), s0 = *(const f32x4*)(cp + 32), s1 = *(const f32x4*)(cp + 36);
#pragma unroll
            for (int j = 0; j < 8; ++j) { const float c = j < 4 ? c0[j & 3] : c1[j & 3], sn = j < 4 ? s0[j & 3] : s1[j & 3];
                const float t1 = qv[8 + kk][j], t2 = qv[10 + kk][j]; qv[8 + kk][j] = t1 * c - t2 * sn; qv[10 + kk][j] = t2 * c + t1 * sn; } } }
    float ss = 0.f;
#pragma unroll
    for (int ks = 0; ks < NKS; ++ks)
#pragma unroll
        for (int j = 0; j < 8; ++j) ss += qv[ks][j] * qv[ks][j];
    ss += __shfl_xor(ss, 32);
    const float rstd = qscale / __builtin_sqrtf(ss * inv_n + eps);
#pragma unroll
    for (int ks = 0; ks < NKS; ++ks) { f32x4 g0 = (f32x4){1.f, 1.f, 1.f, 1.f}, g1 = g0;
        if (gain) { g0 = *(const f32x4*)(gain + 16 * ks + 8 * h); g1 = *(const f32x4*)(gain + 16 * ks + 8 * h + 4); }
        u32x4 p; p.x = pg8::cvt_pk_bf16(qv[ks][0] * rstd * g0[0], qv[ks][1] * rstd * g0[1]); p.y = pg8::cvt_pk_bf16(qv[ks][2] * rstd * g0[2], qv[ks][3] * rstd * g0[3]);
        p.z = pg8::cvt_pk_bf16(qv[ks][4] * rstd * g1[0], qv[ks][5] * rstd * g1[1]); p.w = pg8::cvt_pk_bf16(qv[ks][6] * rstd * g1[2], qv[ks][7] * rstd * g1[3]);
        qf[ks] = __builtin_bit_cast(bf16x8, p); }
}

__device__ __forceinline__ void sb_block(f32x16& s, float& R, int kb0, int tlim, int h, float c2) {
    float z[16], sp[16], G[4], PG[4];
#pragma unroll
    for (int g = 0; g < 4; ++g) {
#pragma unroll
        for (int i = 0; i < 4; ++i) { const int idx = 4 * g + i;
            z[idx] = __builtin_fminf(s[idx] * c2, 60.0f);
            const float spv = __builtin_amdgcn_logf(1.0f + __builtin_amdgcn_exp2f(z[idx]));
            sp[idx] = (kb0 + 8 * g + 4 * h + i < tlim) ? spv : 0.0f; }
        G[g] = (sp[4 * g] + sp[4 * g + 1]) + (sp[4 * g + 2] + sp[4 * g + 3]);
    }
#pragma unroll
    for (int g = 0; g < 4; ++g) PG[g] = __shfl_xor(G[g], 32);
    float run = R;
#pragma unroll
    for (int g = 3; g >= 0; --g) {
        float e = run + (h == 0 ? PG[g] : 0.0f);
#pragma unroll
        for (int i = 3; i >= 0; --i) { const int idx = 4 * g + i;
            const float a = __builtin_amdgcn_exp2f(z[idx] - sp[idx] - e);
            s[idx] = (kb0 + 8 * g + 4 * h + i < tlim) ? a : 0.0f;
            e += sp[idx]; }
        run += G[g] + PG[g];
    }
    R = run;
}

template <int MODE, int DQK, bool QN = false>
__device__ __forceinline__ void attn_unit(ATT_LAS unsigned char* lds, const unsigned short* Q, int ldq, const unsigned short* K, int ldk, const unsigned short* V, int ldv, unsigned short* O, int ldo,
                                          int q0, int jfirst, int jstep, int ntiles, int jd, float c2, float shift, volatile ATT_LAS unsigned* flags, int tid, int lane, int wave) {
    constexpr int NA = DQK / 128, NKS = DQK / 16, NKI = 64 * DQK / 8 / 512;
    const int r = lane & 31, h = lane >> 5;
    const int t = q0 + 32 * wave + r;
    bf16x8 qf[NKS];
    if (QN) load_q_norm<NKS, false>(qf, Q + (size_t)t * ldq, h, nullptr, nullptr, 1.0f / DQK, 1e-6f);
    else { const unsigned short* qp = Q + (size_t)t * ldq + 8 * h;
#pragma unroll
      for (int ks = 0; ks < NKS; ++ks) qf[ks] = *(const bf16x8*)(qp + 16 * ks); }
    f32x16 o[4];
#pragma unroll
    for (int d = 0; d < 4; ++d)
#pragma unroll
        for (int i = 0; i < 16; ++i) o[d][i] = 0.f;
    float R = 0.f;
    int koff[NKI], voff[2];
#pragma unroll
    for (int i = 0; i < NKI; ++i) { const int cidx = tid + 512 * i;
        if (512 * i < NA * 1024) { const int c = cidx & 1023, key = c >> 4, ch = (c & 15) ^ (key & 15); koff[i] = key * ldk + 128 * (cidx >> 10) + 8 * ch; }
        else { const int c = cidx - NA * 1024, rowp = c >> 4, c16 = (c & 15) ^ (rowp & 15); koff[i] = (2 * rowp + (c16 >> 3)) * ldk + 128 * NA + 8 * (c16 & 7); } }
#pragma unroll
    for (int i = 0; i < 2; ++i) { const int cidx = tid + 512 * i; voff[i] = (8 * (cidx >> 7) + ((cidx >> 2) & 7)) * ldv + 32 * ((cidx >> 5) & 3) + 8 * (cidx & 3); }
    const unsigned ldsw = (unsigned)wave * 1024u;
#define ATT_STAGE(j, b) do { const unsigned short* kt_ = K + (size_t)(j) * 64 * ldk; const unsigned short* vt_ = V + (size_t)(j) * 64 * ldv; \
        _Pragma("unroll") for (int i_ = 0; i_ < NKI; ++i_) __builtin_amdgcn_global_load_lds((const unsigned*)(kt_ + koff[i_]), (ATT_LAS unsigned*)(lds + (b) * STAGE + ldsw + i_ * 8192), 16, 0, 0); \
        _Pragma("unroll") for (int i_ = 0; i_ < 2; ++i_) __builtin_amdgcn_global_load_lds((const unsigned*)(vt_ + voff[i_]), (ATT_LAS unsigned*)(lds + (b) * STAGE + KBUF + ldsw + i_ * 8192), 16, 0, 0); } while (0)
    const int a_base = r * 256, x15 = r & 15, b_base = (r >> 1) * 256, b_x = (r >> 1) & 15, b_hi = (r & 1) * 8;
    const unsigned lds0 = (unsigned)(size_t)lds;
    const unsigned v_lane = lds0 + KBUF + (unsigned)((4 * h + ((lane & 15) >> 2)) * 64 + 32 * ((lane >> 4) & 1) + 8 * (lane & 3));

    ATT_STAGE(jfirst, 0);
    for (int it = 0; it < ntiles; ++it) {
        const int j = jfirst + it * jstep, b = it & 1;
        asm volatile("s_waitcnt vmcnt(0)" ::: "memory");
        __syncthreads();
        if (MODE == 0 && it > 0) {
            unsigned all = 1u;
#pragma unroll
            for (int w = 0; w < 8; ++w) all &= flags[((it - 1) & 1) * 8 + w];
            if (__builtin_amdgcn_readfirstlane(all)) break;
        }
        if (it + 1 < ntiles) ATT_STAGE(j + jstep, b ^ 1);
        if (j <= jd) {
            ATT_LAS unsigned char* kb_ = lds + b * STAGE;
            f32x16 s0, s1;
#pragma unroll
            for (int i = 0; i < 16; ++i) { s0[i] = 0.f; s1[i] = 0.f; }
#pragma unroll
            for (int ks = 0; ks < NKS; ++ks) {
                int off0;
                if (ks < 8 * NA) off0 = (ks >> 3) * 16384 + a_base + (((2 * (ks & 7) + h) ^ x15) << 4);
                else off0 = NA * 16384 + b_base + (((b_hi + 2 * (ks - 8 * NA) + h) ^ b_x) << 4);
                const int kbs = (ks < 8 * NA) ? 8192 : 4096;
                const bf16x8 k0 = *(const ATT_LAS bf16x8*)(kb_ + off0), k1 = *(const ATT_LAS bf16x8*)(kb_ + off0 + kbs);
                s0 = ATT_MFMA(k0, qf[ks], s0); s1 = ATT_MFMA(k1, qf[ks], s1);
            }
            if (MODE == 0) { const int tlim = t - 64 * j; sb_block(s1, R, 32, tlim, h, c2); sb_block(s0, R, 0, tlim, h, c2); }
            else {
#pragma unroll
                for (int i = 0; i < 16; ++i) { s0[i] = __builtin_amdgcn_exp2f(s0[i] * c2 - shift); s1[i] = __builtin_amdgcn_exp2f(s1[i] * c2 - shift); }
                float ps = 0.f;
#pragma unroll
                for (int i = 0; i < 16; ++i) ps += s0[i] + s1[i];
                R += ps;
            }
            const bf16x8 p00 = pack_step(s0, 0), p01 = pack_step(s0, 1), p10 = pack_step(s1, 0), p11 = pack_step(s1, 1);
            const unsigned vb = v_lane + (unsigned)(b * STAGE);
#define ATT_PV(KB, ST, PF) do { \
            const s16x4 l0 = tr_read<((4 * KB + 2 * ST) * 4 + 0) * 512>(vb), h0 = tr_read<((4 * KB + 2 * ST + 1) * 4 + 0) * 512>(vb); \
            const s16x4 l1 = tr_read<((4 * KB + 2 * ST) * 4 + 1) * 512>(vb), h1 = tr_read<((4 * KB + 2 * ST + 1) * 4 + 1) * 512>(vb); \
            const s16x4 l2 = tr_read<((4 * KB + 2 * ST) * 4 + 2) * 512>(vb), h2 = tr_read<((4 * KB + 2 * ST + 1) * 4 + 2) * 512>(vb); \
            const s16x4 l3 = tr_read<((4 * KB + 2 * ST) * 4 + 3) * 512>(vb), h3 = tr_read<((4 * KB + 2 * ST + 1) * 4 + 3) * 512>(vb); \
            asm volatile("s_waitcnt lgkmcnt(0)" ::: "memory"); __builtin_amdgcn_sched_barrier(0); \
            o[0] = ATT_MFMA(__builtin_shufflevector(l0, h0, 0, 1, 2, 3, 4, 5, 6, 7), PF, o[0]); \
            o[1] = ATT_MFMA(__builtin_shufflevector(l1, h1, 0, 1, 2, 3, 4, 5, 6, 7), PF, o[1]); \
            o[2] = ATT_MFMA(__builtin_shufflevector(l2, h2, 0, 1, 2, 3, 4, 5, 6, 7), PF, o[2]); \
            o[3] = ATT_MFMA(__builtin_shufflevector(l3, h3, 0, 1, 2, 3, 4, 5, 6, 7), PF, o[3]); } while (0)
            ATT_PV(0, 0, p00); ATT_PV(0, 1, p01); ATT_PV(1, 0, p10); ATT_PV(1, 1, p11);
#undef ATT_PV
        }
        if (MODE == 0) { const unsigned dn = __all(R > 160.0f) ? 1u : 0u; if (lane == 0) flags[b * 8 + wave] = dn; }
    }
    float inv = 1.0f;
    if (MODE == 1) inv = 1.0f / (R + __shfl_xor(R, 32));
    unsigned short* op = O + (size_t)t * ldo + 4 * h;
#pragma unroll
    for (int d = 0; d < 4; ++d)
#pragma unroll
        for (int g = 0; g < 4; ++g) { u32x2 w; w.x = pg8::cvt_pk_bf16(o[d][4 * g] * inv, o[d][4 * g + 1] * inv); w.y = pg8::cvt_pk_bf16(o[d][4 * g + 2] * inv, o[d][4 * g + 3] * inv);
            *(u32x2*)(op + 32 * d + 8 * g) = w; }
#undef ATT_STAGE
}

template <int DQK>
__device__ __forceinline__ void attn_unit_sm3(ATT_LAS unsigned char* lds, const unsigned short* Q, int ldq, const unsigned short* K, int ldk, const unsigned short* V, int ldv, unsigned short* O, int ldo,
                                              int q0, int ntiles, int jd, float c2, float shift, int tid, int lane, int wave, const float* rc, const float* gq) {
    static_assert(DQK == 192, "padded K image below is laid out for 128 + 64 key dims");
    constexpr int NKS = DQK / 16, KA_BYTES = 64 * 272, KB_BYTES = 64 * 144, VOFF = KA_BYTES + KB_BYTES, STG = VOFF + 16384;
    static_assert(3 * STG <= 131072, "ring");
    const int r = lane & 31, h = lane >> 5;
    const int t = q0 + 32 * wave + r;
    const bool trail = wave >= 4;
    bf16x8 qf[NKS];
    load_q_norm<NKS, true>(qf, Q + (size_t)t * ldq, h, rc + (size_t)t * 64, gq, 1.0f / DQK, 1e-6f, c2);
    f32x16 o[4];
#pragma unroll
    for (int d = 0; d < 4; ++d)
#pragma unroll
        for (int i = 0; i < 16; ++i) o[d][i] = 0.f;
    float R = 0.f;
    int koff[4], voff[2];
    { const int qa0 = tid, qa1 = tid + 512, qb0 = tid;
      koff[0] = (qa0 / 17) * ldk + 8 * ((qa0 % 17) < 16 ? (qa0 % 17) : 0);
      koff[1] = (qa1 / 17) * ldk + 8 * ((qa1 % 17) < 16 ? (qa1 % 17) : 0);
      koff[2] = (qb0 / 9) * ldk + 128 + 8 * ((qb0 % 9) < 8 ? (qb0 % 9) : 0);
      const int qx = (wave == 0) ? 1024 + lane : 512 + lane;
      koff[3] = (wave == 0) ? (qx / 17) * ldk + 8 * ((qx % 17) < 16 ? (qx % 17) : 0) : (qx / 9) * ldk + 128 + 8 * ((qx % 9) < 8 ? (qx % 9) : 0); }
#pragma unroll
    for (int i = 0; i < 2; ++i) { const int cidx = tid + 512 * i; voff[i] = (8 * (cidx >> 7) + ((cidx >> 2) & 7)) * ldv + 32 * ((cidx >> 5) & 3) + 8 * (cidx & 3); }
    const unsigned ldsw = (unsigned)wave * 1024u;
#define ATT_DMA(src, dstoff) __builtin_amdgcn_global_load_lds((const unsigned*)(src), (ATT_LAS unsigned*)(lds + (dstoff)), 16, 0, 0)
#define ATT_STAGE3(j, sg) do { const unsigned short* kt_ = K + (size_t)(j) * 64 * ldk; const unsigned short* vt_ = V + (size_t)(j) * 64 * ldv; \
        ATT_DMA(kt_ + koff[0], (sg) * STG + ldsw); ATT_DMA(kt_ + koff[1], (sg) * STG + 8192 + ldsw); ATT_DMA(kt_ + koff[2], (sg) * STG + KA_BYTES + ldsw); \
        if (wave == 0) ATT_DMA(kt_ + koff[3], (sg) * STG + 16384); else if (wave == 1) ATT_DMA(kt_ + koff[3], (sg) * STG + KA_BYTES + 8192); \
        ATT_DMA(vt_ + voff[0], (sg) * STG + VOFF + ldsw); ATT_DMA(vt_ + voff[1], (sg) * STG + VOFF + 8192 + ldsw); } while (0)
    const unsigned lds0 = (unsigned)(size_t)lds;
    const unsigned ka_lane = lds0 + (unsigned)(r * 272 + h * 16), kb_lane = lds0 + (unsigned)(KA_BYTES + r * 144 + h * 16);
    const unsigned v_lane = lds0 + VOFF + (unsigned)((4 * h + ((lane & 15) >> 2)) * 64 + 32 * ((lane >> 4) & 1) + 8 * (lane & 3));

    ATT_STAGE3(0, 0);
    if (ntiles > 1) ATT_STAGE3(1, 1);
    asm volatile("s_waitcnt vmcnt(0)" ::: "memory");
    if (trail) __builtin_amdgcn_s_barrier();
    __builtin_amdgcn_s_barrier();
    int sc = 0;
    for (int j = 0; j < ntiles; ++j) {
        f32x16 s0, s1; bf16x8 p00, p01;
        if (j <= jd) {
#pragma unroll
            for (int i = 0; i < 16; ++i) { s0[i] = 0.f; s1[i] = 0.f; }
#define ATT_KRD_IMM(dst, addr, IMM) asm volatile("ds_read_b128 %0, %1 offset:%2" : "=&v"(dst) : "v"(addr), "i"(IMM) : "memory")
#define ATT_KRDF(dst, F) do { if (((F) % 12) < 8) ATT_KRD_IMM(dst, kaA, ((F) / 12) * (32 * 272) + ((F) % 12) * 32); \
            else ATT_KRD_IMM(dst, kaB, ((F) / 12) * (32 * 144) + ((((F) % 12) >= 8) ? ((F) % 12 - 8) : 0) * 32); } while (0)
#define ATT_A_STEP(F) do { \
            if ((F) + 3 < 24) { ATT_KRDF(kf[((F) + 3) & 3], (F) + 3); asm volatile("s_waitcnt lgkmcnt(3)" ::: "memory"); } \
            else if ((F) + 3 == 24) asm volatile("s_waitcnt lgkmcnt(2)" ::: "memory"); \
            else if ((F) + 2 == 24) asm volatile("s_waitcnt lgkmcnt(1)" ::: "memory"); \
            else asm volatile("s_waitcnt lgkmcnt(0)" ::: "memory"); \
            __builtin_amdgcn_sched_barrier(0); \
            if ((F) < 12) s0 = ATT_MFMA(kf[(F) & 3], qf[(F) % 12], s0); else s1 = ATT_MFMA(kf[(F) & 3], qf[(F) % 12], s1); \
            __builtin_amdgcn_sched_barrier(0); \
            if ((F) > 12) { _Pragma("unroll") for (int e_ = (16 * ((F) - 13)) / 11; e_ < (16 * ((F) - 12)) / 11; ++e_) { s0[e_] = __builtin_amdgcn_exp2f(s0[e_]); if (e_ & 1) psb += s0[e_]; else psa += s0[e_]; } \
                __builtin_amdgcn_sched_barrier(0); } } while (0)
            const unsigned kaA = ka_lane + (unsigned)(sc * STG), kaB = kb_lane + (unsigned)(sc * STG);
            bf16x8 kf[4];
            ATT_KRDF(kf[0], 0); ATT_KRDF(kf[1], 1); ATT_KRDF(kf[2], 2);
            float psa = 0.f, psb = 0.f;
            ATT_A_STEP(0); ATT_A_STEP(1); ATT_A_STEP(2); ATT_A_STEP(3); ATT_A_STEP(4); ATT_A_STEP(5); ATT_A_STEP(6); ATT_A_STEP(7); ATT_A_STEP(8); ATT_A_STEP(9); ATT_A_STEP(10); ATT_A_STEP(11);
            ATT_A_STEP(12); ATT_A_STEP(13); ATT_A_STEP(14); ATT_A_STEP(15); ATT_A_STEP(16); ATT_A_STEP(17); ATT_A_STEP(18); ATT_A_STEP(19); ATT_A_STEP(20); ATT_A_STEP(21); ATT_A_STEP(22); ATT_A_STEP(23);
            R += psa + psb;
#undef ATT_KRD_IMM
#undef ATT_KRDF
#undef ATT_A_STEP
            p00 = pack_step(s0, 0); p01 = pack_step(s0, 1);
        }
        asm volatile("s_waitcnt vmcnt(0)" ::: "memory");
        __builtin_amdgcn_s_barrier();
        if (j + 2 < ntiles) { const int sn = sc == 0 ? 2 : sc - 1; ATT_STAGE3(j + 2, sn); }
        if (j <= jd) {
            const unsigned vb = v_lane + (unsigned)(sc * STG);
#define ATT_VLD(KB, ST, D, L, H) do { \
            L[0] = tr_read<((4 * KB + 2 * ST) * 4 + D) * 512>(vb); H[0] = tr_read<((4 * KB + 2 * ST + 1) * 4 + D) * 512>(vb); \
            L[1] = tr_read<((4 * KB + 2 * ST) * 4 + D + 1) * 512>(vb); H[1] = tr_read<((4 * KB + 2 * ST + 1) * 4 + D + 1) * 512>(vb); } while (0)
#define ATT_PVM(D, L, H, PF) do { \
            o[D] = ATT_MFMA(__builtin_shufflevector(L[0], H[0], 0, 1, 2, 3, 4, 5, 6, 7), PF, o[D]); \
            o[D + 1] = ATT_MFMA(__builtin_shufflevector(L[1], H[1], 0, 1, 2, 3, 4, 5, 6, 7), PF, o[D + 1]); } while (0)
#define ATT_W(n) do { asm volatile("s_waitcnt lgkmcnt(" #n ")" ::: "memory"); __builtin_amdgcn_sched_barrier(0); } while (0)
#define ATT_SM1(E0) do { __builtin_amdgcn_sched_barrier(0); _Pragma("unroll") for (int e_ = (E0); e_ < (E0) + 4; ++e_) { s1[e_] = __builtin_amdgcn_exp2f(s1[e_]); if (e_ & 1) psb += s1[e_]; else psa += s1[e_]; } \
            __builtin_amdgcn_sched_barrier(0); } while (0)
            float psa = 0.f, psb = 0.f;
            s16x4 la[2], ha[2], lb[2], hb[2], lc[2], hc[2];
            ATT_VLD(0, 0, 0, la, ha); ATT_VLD(0, 0, 2, lb, hb);
            ATT_VLD(0, 1, 0, lc, hc); ATT_W(8); ATT_PVM(0, la, ha, p00); ATT_SM1(0);
            ATT_VLD(0, 1, 2, la, ha); ATT_W(8); ATT_PVM(2, lb, hb, p00); ATT_SM1(4);
            ATT_VLD(1, 0, 0, lb, hb); ATT_W(8); ATT_PVM(0, lc, hc, p01); ATT_SM1(8);
            ATT_VLD(1, 0, 2, lc, hc); ATT_W(8); ATT_PVM(2, la, ha, p01); ATT_SM1(12);
            R += psa + psb;
            const bf16x8 p10 = pack_step(s1, 0);
            ATT_VLD(1, 1, 0, la, ha); ATT_W(8); ATT_PVM(0, lb, hb, p10); __builtin_amdgcn_sched_barrier(0);
            ATT_VLD(1, 1, 2, lb, hb); ATT_W(8); ATT_PVM(2, lc, hc, p10); __builtin_amdgcn_sched_barrier(0);
            const bf16x8 p11 = pack_step(s1, 1);
            ATT_W(4); ATT_PVM(0, la, ha, p11); __builtin_amdgcn_sched_barrier(0);
            ATT_W(0); ATT_PVM(2, lb, hb, p11);
#undef ATT_SM1
#undef ATT_VLD
#undef ATT_PVM
#undef ATT_W
        }
        __builtin_amdgcn_s_barrier();
        sc = sc == 2 ? 0 : sc + 1;
    }
    if (!trail) __builtin_amdgcn_s_barrier();
    const float inv = 1.0f / (R + __shfl_xor(R, 32));
    unsigned short* op = O + (size_t)t * ldo + 4 * h;
#pragma unroll
    for (int d = 0; d < 4; ++d)
#pragma unroll
        for (int g = 0; g < 4; ++g) { u32x2 w; w.x = pg8::cvt_pk_bf16(o[d][4 * g] * inv, o[d][4 * g + 1] * inv); w.y = pg8::cvt_pk_bf16(o[d][4 * g + 2] * inv, o[d][4 * g + 3] * inv);
            *(u32x2*)(op + 32 * d + 8 * g) = w; }
#undef ATT_STAGE3
#undef ATT_DMA
}
}


#ifndef NLAUNCH
#define NLAUNCH 1
#endif
constexpr int NWAVES = 8, NPH = 10;
constexpr int S = 8192, D = 4096, NMEM = 256, NIN = 19392, NP = 19456, DFF = 16384;
constexpr int C_SBQ = 0, C_SBK = 1536, C_SBV = 3072, C_CQ = 4608, C_CKV = 5504, C_KPE = 6016, C_PAD = 6080, C_MEMQ = 6144, C_GATE = 7168;
constexpr int QLORA = 896, KVLORA = 512, NQB = 2304, NKVB = 3072, MEMW = 1024;
constexpr float EPS = 1e-6f;
#ifndef LDU
#define LDU (DFF + 64)
#endif

#define GAS __attribute__((address_space(1)))
#define LAS __attribute__((address_space(3)))
typedef unsigned short bf16;
typedef unsigned u32x4 __attribute__((ext_vector_type(4)));
typedef float f32x4 __attribute__((ext_vector_type(4)));

constexpr size_t MiB = 1u << 20;
constexpr size_t WS_CTL = 0, CTL_ZERO_BYTES = 1 * MiB, CTL_SSQ_OFF = 512 * 1024;
constexpr size_t WS_WIN = 1 * MiB, WS_WFF1 = 153 * MiB, WS_WFF2 = 281 * MiB, WS_WOUT = 409 * MiB, WS_WSBO = 441 * MiB, WS_WMLAO = 453 * MiB, WS_WMEMO = 465 * MiB,
                 WS_WMEMKV = 473 * MiB, WS_WQB = 489 * MiB, WS_WKVB = 493 * MiB;
constexpr size_t WS_H = 496 * MiB, WS_QRAW = 560 * MiB, WS_KVRAW = 596 * MiB, WS_PACC = WS_H  ;
constexpr size_t WS_PROJ = 644 * MiB, WS_U = WS_PROJ  ;
constexpr size_t WS_HM = 948 * MiB, WS_CQN = 950 * MiB, WS_CKVN = 964 * MiB, WS_KROT = 972 * MiB, WS_ROPECS = 974 * MiB, WS_QF = 976 * MiB, WS_KF = 1012 * MiB, WS_QM = 1048 * MiB,
                 WS_MKV = 1064 * MiB, WS_MKF = 1065 * MiB, WS_OSB = 1066 * MiB, WS_OMLA = 1090 * MiB, WS_OMEM = 1114 * MiB, WS_END = 1130 * MiB;
constexpr size_t WS_WCAT = WS_WSBO, WS_OCAT = WS_OSB;
constexpr size_t WS_X1B = WS_H;
constexpr size_t WS_MERGED = WS_WIN, WS_XG = WS_WIN + 64 * MiB;
static_assert(WS_WIN + (size_t)NP * D * 2 <= WS_WFF1 && WS_PACC + (size_t)S * D * 4 <= WS_PROJ && WS_PROJ + (size_t)S * NP * 2 <= WS_HM && WS_U + (size_t)S * (DFF + 64) * 2 <= WS_HM, "ws map");
static_assert(WS_XG + (size_t)S * D * 2 <= WS_WFF1 && WS_QRAW + (size_t)S * NQB * 2 <= WS_KVRAW && WS_KVRAW + (size_t)S * NKVB * 2 <= WS_PROJ, "ws map 2");
constexpr int CW_BAR = 4096;

constexpr int RING_BYTES = 131072, LDSCTL_OFF = RING_BYTES, LDS_BYTES = 147456;

#define XB_TMO      128
#define XB_XCNT(j)  (256  + 64 * (j))
#define XB_XSUB(j)  (1280 + 64 * (j))
#define XB_XGEN(j)  (2304 + 64 * (j))
#define XB_TOP      3328
#define XB_TOPGEN   3392
#define XCD_BAR_WORDS 3456
#define XB_SPIN_CAP (1u << 18)
__device__ __forceinline__ unsigned xb_ld(unsigned* p)              { return __hip_atomic_load(p, __ATOMIC_RELAXED, __HIP_MEMORY_SCOPE_AGENT); }
__device__ __forceinline__ unsigned xb_add(unsigned* p, unsigned v) { return __hip_atomic_fetch_add(p, v, __ATOMIC_RELAXED, __HIP_MEMORY_SCOPE_AGENT); }
__device__ __forceinline__ unsigned xb_xcc_id() { return (unsigned)__builtin_amdgcn_s_getreg((3 << 11) | 20) & 0xFu; }
#define XB_SPIN(cond, bar) do { unsigned _sp = 0; while (cond) { __builtin_amdgcn_s_sleep(1); \
    if ((++_sp & 255u) == 0u) { if (xb_ld(&(bar)[XB_TMO])) break; if (_sp > XB_SPIN_CAP) { atomicAdd(&(bar)[XB_TMO], 1u); break; } } } } while (0)
struct XcdBarrier { unsigned* bar; unsigned x; volatile LAS unsigned* st; };
__device__ __forceinline__ XcdBarrier xcd_barrier_post(unsigned* bar, volatile LAS unsigned* st) {
    XcdBarrier b; b.bar = bar; b.x = xb_xcc_id(); b.st = st;
    if (threadIdx.x == 0) (void)xb_add(&bar[XB_XCNT(b.x)], 1u);
    return b;
}
__device__ __forceinline__ void xcd_barrier_complete(unsigned* bar, unsigned x, unsigned& nloc, unsigned& nx) {
    const unsigned G = gridDim.x * gridDim.y * gridDim.z;
    unsigned sum, cnt, mine, sp = 0u;
    for (;;) {
        sum = 0u; cnt = 0u; mine = 0u;
#pragma unroll
        for (unsigned j = 0; j < 16; ++j) { const unsigned c = xb_ld(&bar[XB_XCNT(j)]); sum += c; cnt += (c > 0u) ? 1u : 0u; mine = (j == x) ? c : mine; }
        if (sum == G) break;
        __builtin_amdgcn_s_sleep(1);
        if ((++sp & 255u) == 0u) { if (xb_ld(&bar[XB_TMO])) break; if (sp > XB_SPIN_CAP) { atomicAdd(&bar[XB_TMO], 1u); break; } }
    }
    nloc = mine > 0u ? mine : 1u; nx = cnt > 0u ? cnt : 1u;
}
__device__ __forceinline__ void xcd_barrier(const XcdBarrier& b) {
    asm volatile("s_waitcnt vmcnt(0)" ::: "memory");
    __syncthreads();
    if (threadIdx.x == 0) {
        unsigned* bar = b.bar;
        __builtin_amdgcn_s_waitcnt(0);
        unsigned nloc = b.st[0], nx = b.st[1];
        if (nloc == 0u) { xcd_barrier_complete(bar, b.x, nloc, nx); b.st[0] = nloc; b.st[1] = nx; }
        const unsigned old = xb_add(&bar[XB_XSUB(b.x)], 1u);
        const unsigned gen = old / nloc;
        if (old + 1u == (gen + 1u) * nloc) {
            __builtin_amdgcn_fence(__ATOMIC_RELEASE, "agent");
            asm volatile("s_waitcnt vmcnt(0)" ::: "memory");
            const unsigned og = xb_add(&bar[XB_TOP], 1u);
            const unsigned tg = og / nx;
            if (og + 1u == (tg + 1u) * nx) xb_add(&bar[XB_TOPGEN], 1u);
            else XB_SPIN(xb_ld(&bar[XB_TOPGEN]) == tg, bar);
            __builtin_amdgcn_fence(__ATOMIC_ACQUIRE, "agent");
            xb_add(&bar[XB_XGEN(b.x)], 1u);
            asm volatile("s_waitcnt vmcnt(0)" ::: "memory");
        } else {
            XB_SPIN(xb_ld(&bar[XB_XGEN(b.x)]) == gen, bar);
            __builtin_amdgcn_fence(__ATOMIC_ACQUIRE, "agent");
            asm volatile("s_waitcnt vmcnt(0)" ::: "memory");
        }
    }
    __syncthreads();
}

__device__ __forceinline__ float bf2f_lo(unsigned w) { return __builtin_bit_cast(float, w << 16); }
__device__ __forceinline__ float bf2f_hi(unsigned w) { return __builtin_bit_cast(float, w & 0xffff0000u); }
__device__ __forceinline__ void unpack8(const u32x4 w, float (&v)[8]) { v[0] = bf2f_lo(w.x); v[1] = bf2f_hi(w.x); v[2] = bf2f_lo(w.y); v[3] = bf2f_hi(w.y); v[4] = bf2f_lo(w.z); v[5] = bf2f_hi(w.z); v[6] = bf2f_lo(w.w); v[7] = bf2f_hi(w.w); }
__device__ __forceinline__ u32x4 pack8(const float (&v)[8]) { u32x4 w; w.x = pg8::cvt_pk_bf16(v[0], v[1]); w.y = pg8::cvt_pk_bf16(v[2], v[3]); w.z = pg8::cvt_pk_bf16(v[4], v[5]); w.w = pg8::cvt_pk_bf16(v[6], v[7]); return w; }
__device__ __forceinline__ float wave_sum(float v) {
#pragma unroll
    for (int o = 1; o < 64; o <<= 1) v += __shfl_xor(v, o);
    return v;
}
__device__ __forceinline__ float half_sum(float v) {
#pragma unroll
    for (int o = 1; o < 32; o <<= 1) v += __shfl_xor(v, o);
    return v;
}

struct Args { const float* in[22]; float* out; unsigned char* ws; int ph_lo, ph_hi, li, pad; };

#ifndef P9_WGM
#define P9_WGM 8
#endif
#ifndef FF1_DEFER
#define FF1_DEFER 0
#endif
__device__ __forceinline__ void tr_tile(const float* __restrict__ W, int K, int N, bf16* __restrict__ WT, int ldt, int dst_row, int k0, int kdst, int n0, LAS unsigned char* scr, int lane, const float* kscale = nullptr) {
    const int nc = lane & 15, kp0 = lane >> 4;
    f32x4 va[8], vb[8];
#pragma unroll
    for (int i = 0; i < 8; ++i) { const float* p = W + (size_t)(k0 + 2 * (kp0 + 4 * i)) * N + n0 + 4 * nc; va[i] = *(const f32x4*)p; vb[i] = *(const f32x4*)(p + N); }
#pragma unroll
    for (int i = 0; i < 8; ++i) { const int kp = kp0 + 4 * i;
        if (kscale) { const float s0 = kscale[k0 + 2 * kp], s1 = kscale[k0 + 2 * kp + 1]; va[i] = va[i] * s0; vb[i] = vb[i] * s1; }
#pragma unroll
        for (int j = 0; j < 4; ++j) { const int n = 4 * nc + j;
            *(LAS unsigned*)(scr + n * 128 + (((kp >> 2) ^ (nc & 7)) << 4) + ((kp & 3) << 2)) = pg8::cvt_pk_bf16(va[i][j], vb[i][j]); } }
    asm volatile("s_waitcnt lgkmcnt(0)" ::: "memory");
    const int c = lane & 7;
#pragma unroll
    for (int jj = 0; jj < 8; ++jj) { const int n = (lane >> 3) + 8 * jj;
        const u32x4 v = *(const LAS u32x4*)(scr + n * 128 + ((c ^ ((n >> 2) & 7)) << 4));
        *(u32x4*)(WT + (size_t)(dst_row + n) * ldt + kdst + 8 * c) = v; }
    asm volatile("s_waitcnt lgkmcnt(0)" ::: "memory");
}
__device__ __forceinline__ bool tr_mat(int& r, const float* W, int K, int N, bf16* WT, bool is_win, LAS unsigned char* scr, int lane, int ldt = 0, int koff = 0, const float* kscale = nullptr) {
    const int nb = N / 64, items = (K / 64) * nb;
    if (r >= items) { r -= items; return false; }
    const int kb = r / nb, n0 = (r % nb) * 64;
    tr_tile(W, K, N, WT, ldt ? ldt : K, is_win ? (n0 + (n0 >= C_PAD ? 64 : 0)) : n0, kb * 64, koff + kb * 64, n0, scr, lane, kscale);
    return true;
}
struct TrDesc { const float* W; bf16* WT; int N, ldt, dst_row, k0, kdst, n0; };
__device__ __forceinline__ void tr_load(const TrDesc& d, f32x4 (&va)[8], f32x4 (&vb)[8], int lane) {
    const int nc = lane & 15, kp0 = lane >> 4;
#pragma unroll
    for (int i = 0; i < 8; ++i) { const float* p = d.W + (size_t)(d.k0 + 2 * (kp0 + 4 * i)) * d.N + d.n0 + 4 * nc; va[i] = *(const f32x4*)p; vb[i] = *(const f32x4*)(p + d.N); }
}
__device__ __forceinline__ void tr_store(const TrDesc& d, const f32x4 (&va)[8], const f32x4 (&vb)[8], LAS unsigned char* scr, int lane) {
    const int nc = lane & 15, kp0 = lane >> 4;
#pragma unroll
    for (int i = 0; i < 8; ++i) { const int kp = kp0 + 4 * i;
#pragma unroll
        for (int j = 0; j < 4; ++j) { const int n = 4 * nc + j;
            *(LAS unsigned*)(scr + n * 128 + (((kp >> 2) ^ (nc & 7)) << 4) + ((kp & 3) << 2)) = pg8::cvt_pk_bf16(va[i][j], vb[i][j]); } }
    asm volatile("s_waitcnt lgkmcnt(0)" ::: "memory");
    const int c = lane & 7;
#pragma unroll
    for (int jj = 0; jj < 8; ++jj) { const int n = (lane >> 3) + 8 * jj;
        const u32x4 v = *(const LAS u32x4*)(scr + n * 128 + ((c ^ ((n >> 2) & 7)) << 4));
        *(u32x4*)(d.WT + (size_t)(d.dst_row + n) * d.ldt + d.kdst + 8 * c) = v; }
    asm volatile("s_waitcnt lgkmcnt(0)" ::: "memory");
}
__device__ __forceinline__ bool tr_desc_mat(int& r, TrDesc& d, const float* W, int K, int N, bf16* WT, bool is_win) {
    const int nb = N / 64, items = (K / 64) * nb;
    if (r >= items) { r -= items; return false; }
    const int kb = r / nb, n0 = (r % nb) * 64;
    d.W = W; d.WT = WT; d.N = N; d.ldt = K; d.dst_row = is_win ? (n0 + (n0 >= C_PAD ? 64 : 0)) : n0; d.k0 = kb * 64; d.kdst = kb * 64; d.n0 = n0;
    return true;
}
__device__ __forceinline__ void rms_row_4096(const float* xrow, const float* g, bf16* orow, int lane) {
    const f32x4* xr = (const f32x4*)xrow + lane; f32x4 v[16]; float s = 0.f;
#pragma unroll
    for (int j = 0; j < 16; ++j) { v[j] = xr[64 * j]; s += (v[j].x * v[j].x + v[j].y * v[j].y) + (v[j].z * v[j].z + v[j].w * v[j].w); }
    const float rstd = 1.0f / __builtin_sqrtf(wave_sum(s) * (1.0f / 4096.0f) + EPS);
    unsigned long long* o8 = (unsigned long long*)orow + lane;
#pragma unroll
    for (int j = 0; j < 16; ++j) { const f32x4 gg = ((const f32x4*)g)[lane + 64 * j];
        o8[64 * j] = (unsigned long long)pg8::cvt_pk_bf16(v[j].x * rstd * gg.x, v[j].y * rstd * gg.y) | ((unsigned long long)pg8::cvt_pk_bf16(v[j].z * rstd * gg.z, v[j].w * rstd * gg.w) << 32); }
}
template <int WHICH>
__device__ __forceinline__ void tr_pipeline(const Args& a, LAS unsigned char* scr, int gw, int NGW, int lane) {
    unsigned char* ws = a.ws;
    constexpr int NITEMS = WHICH == 0 ? 64 * 303 + 64 * 32 : 64 * 256;
    auto desc = [&](int it, TrDesc& d) { int r = it;
        if (WHICH == 0) { if (tr_desc_mat(r, d, a.in[5], D, NIN, (bf16*)(ws + WS_WIN), true)) return;
                          tr_desc_mat(r, d, a.in[12], D, 2048, (bf16*)(ws + WS_WMEMKV), false); }
        else if (WHICH == 1) tr_desc_mat(r, d, a.in[20], D, DFF, (bf16*)(ws + WS_WFF1), false);
        else { tr_desc_mat(r, d, a.in[21], DFF, D, (bf16*)(ws + WS_WFF2), false); d.ldt = LDU; } };
    if (gw < NITEMS) {
        TrDesc d0; f32x4 va[8], vb[8];
        desc(gw, d0); tr_load(d0, va, vb, lane);
        for (int it = gw; it < NITEMS; it += NGW) {
            TrDesc d1 = d0; f32x4 na[8], nb[8];
            const bool more = it + NGW < NITEMS;
            if (more) { desc(it + NGW, d1); tr_load(d1, na, nb, lane); }
            tr_store(d0, va, vb, scr, lane);
            if (more) { d0 = d1;
#pragma unroll
                for (int i = 0; i < 8; ++i) { va[i] = na[i]; vb[i] = nb[i]; } }
        }
    }
}
__device__ __forceinline__ void p0_prologue(const Args& a, LAS unsigned char* lds, int gw, int NGW, int wave, int lane) {
    unsigned char* ws = a.ws;
    LAS unsigned char* scr = lds + wave * 8192;
    tr_pipeline<0>(a, scr, gw, NGW, lane);
    for (int i = gw * 64 + lane; i < 64 * D * 2 / 16; i += NGW * 64) ((u32x4*)(ws + WS_WIN + (size_t)C_PAD * D * 2))[i] = (u32x4){0u, 0u, 0u, 0u};
    for (int m = gw; m < S; m += NGW) rms_row_4096(a.in[0] + (size_t)m * D, a.in[3], (bf16*)(ws + WS_H) + (size_t)m * D, lane);
    for (int m = gw; m < NMEM; m += NGW) rms_row_4096(a.in[1] + (size_t)m * D, a.in[4], (bf16*)(ws + WS_HM) + (size_t)m * D, lane);
    {
        const int* pos = (const int*)a.in[2]; const int c = lane & 31;
        const double freq = exp2(-(double)c * (13.287712379549449 / 32.0));
        for (int r = 2 * gw + (lane >> 5); r < S; r += 2 * NGW) { double sn_, cs_; sincos((double)pos[r] * freq, &sn_, &cs_);
            float* rcw = (float*)(ws + WS_ROPECS) + (size_t)r * 64; rcw[c] = (float)cs_; rcw[32 + c] = (float)sn_; } }
}

__device__ __forceinline__ void p1_deferred_convert(const Args& a, LAS unsigned char* lds, int gw2, int NGW2, int wave, int lane) {
    unsigned char* ws = a.ws;
    LAS unsigned char* scr = lds + wave * 8192;
    constexpr int NITEMS = 64 * 64 + 24 * 64 + 24 * 64 + 16 * 64 + 14 * 36 + 8 * 48 + FF1_DEFER;
    for (int it = gw2; it < NITEMS; it += NGW2) {
        int r = it;
        if (tr_mat(r, a.in[8], QLORA, NQB, (bf16*)(ws + WS_WQB), false, scr, lane, 0, 0, a.in[6])) continue;
        if (tr_mat(r, a.in[9], KVLORA, NKVB, (bf16*)(ws + WS_WKVB), false, scr, lane, 0, 0, a.in[7])) continue;
        if (tr_mat(r, a.in[15], 1536, D, (bf16*)(ws + WS_WCAT), false, scr, lane, D, 0)) continue;
        if (tr_mat(r, a.in[16], 1536, D, (bf16*)(ws + WS_WCAT), false, scr, lane, D, 1536)) continue;
        if (tr_mat(r, a.in[17], 1024, D, (bf16*)(ws + WS_WCAT), false, scr, lane, D, 3072)) continue;
        if (tr_mat(r, a.in[18], D, D, (bf16*)(ws + WS_WOUT), false, scr, lane)) continue;
        tr_mat(r, a.in[20], D, DFF, (bf16*)(ws + WS_WFF1), false, scr, lane);
    }
}

__device__ __forceinline__ void k_finalize_tile(const Args& a, int pm, int hh, int wave, int lane) {
    unsigned char* ws = a.ws;
    const int c = lane & 31, hsel = lane >> 5;
    const int cc = c < 24 ? c : 23;
    float gkv[8];
#pragma unroll
    for (int i = 0; i < 8; ++i) gkv[i] = a.in[11][8 * cc + i];
    const int ib = 8 * ((cc - 16) & 3); const float sg = cc < 20 ? -1.f : 1.f;
#pragma unroll 2
    for (int it = 0; it < 16; ++it) {
        const int r = pm * 256 + wave * 32 + 2 * it + hsel;
        const bf16* pr = (const bf16*)(ws + WS_PROJ) + (size_t)r * NP;
        const u32x4 kn = *(const u32x4*)((const bf16*)(ws + WS_KVRAW) + (size_t)r * NKVB + hh * 256 + 8 * (cc & 15));
        const u32x4 kpw = *(const u32x4*)(pr + C_KPE + 8 * ((cc - 16) & 7));
        const float* rc = (const float*)(ws + WS_ROPECS) + (size_t)r * 64 + ib;
        const f32x4 c0 = *(const f32x4*)rc, c1 = *(const f32x4*)(rc + 4), s0 = *(const f32x4*)(rc + 32), s1 = *(const f32x4*)(rc + 36);
        float v[8];
        if (cc < 16) unpack8(kn, v);
        else { float kp[8]; unpack8(kpw, kp);
#pragma unroll
            for (int i = 0; i < 8; ++i) v[i] = kp[i]; }
        float pk[8];
#pragma unroll
        for (int i = 0; i < 8; ++i) pk[i] = __shfl_xor(v[i], 4);
        if (cc >= 16) {
#pragma unroll
            for (int i = 0; i < 8; ++i) { const float cs_ = i < 4 ? c0[i & 3] : c1[i & 3], sn_ = i < 4 ? s0[i & 3] : s1[i & 3]; v[i] = v[i] * cs_ + sg * pk[i] * sn_; } }
        float ss = 0.f;
#pragma unroll
        for (int i = 0; i < 8; ++i) ss += v[i] * v[i];
        if (c >= 24) ss = 0.f;
        const float rstd = 1.0f / __builtin_sqrtf(half_sum(ss) * (1.0f / 192.0f) + EPS);
#pragma unroll
        for (int i = 0; i < 8; ++i) v[i] *= rstd * gkv[i];
        if (c < 24) *(u32x4*)((bf16*)(ws + WS_KF) + (size_t)r * NQB + hh * 192 + 8 * c) = pack8(v);
    }
}
__device__ __forceinline__ void mk_finalize_tile(const Args& a, int hh, int wave, int lane) {
    unsigned char* ws = a.ws;
    const int c = lane & 31, hsel = lane >> 5;
    float gmv[8];
#pragma unroll
    for (int i = 0; i < 8; ++i) gmv[i] = a.in[14][8 * c + i] * a.in[13][8 * c + i];
#pragma unroll 2
    for (int it = 0; it < 16; ++it) {
        const int r = wave * 32 + 2 * it + hsel;
        float v[8]; unpack8(*(const u32x4*)((const bf16*)(ws + WS_MKV) + (size_t)r * 2048 + hh * 256 + 8 * c), v);
        float ss = 0.f;
#pragma unroll
        for (int i = 0; i < 8; ++i) ss += v[i] * v[i];
        const float rstd = 1.0f / __builtin_sqrtf(half_sum(ss) * (1.0f / 256.0f) + EPS);
#pragma unroll
        for (int i = 0; i < 8; ++i) v[i] *= rstd * gmv[i];
        *(u32x4*)((bf16*)(ws + WS_MKF) + (size_t)r * MEMW + hh * 256 + 8 * c) = pack8(v);
    }
}

constexpr int CW_QUEUE = 8192;
__device__ __forceinline__ int next_unit(unsigned* ctr, volatile LAS unsigned* slot, int tid) {
    __syncthreads();
    if (tid == 0) *slot = atomicAdd(ctr, 1u);
    __syncthreads();
    return __builtin_amdgcn_readfirstlane((int)*slot);
}
__device__ __forceinline__ void p5_attention(const Args& a, LAS unsigned char* lds, int tid, int lane, int wave, int qsel) {
    unsigned char* ws = a.ws;
    const bf16* proj = (const bf16*)(ws + WS_PROJ);
    volatile LAS unsigned* flags = (volatile LAS unsigned*)(lds + LDSCTL_OFF + 128);
    volatile LAS unsigned* slot = (volatile LAS unsigned*)(lds + LDSCTL_OFF + 256);
    unsigned* qc = (unsigned*)(ws + WS_CTL) + CW_QUEUE + 1024 * qsel;
    float gq = 0.f, gk = 0.f, gm = 0.f;
    for (int i = lane; i < 192; i += 64) { gq = __builtin_fmaxf(gq, __builtin_fabsf(a.in[10][i])); gk = __builtin_fmaxf(gk, __builtin_fabsf(a.in[11][i])); }
    for (int i = lane; i < 256; i += 64) gm = __builtin_fmaxf(gm, __builtin_fabsf(a.in[13][i] * a.in[14][i]));
#pragma unroll
    for (int o = 1; o < 64; o <<= 1) { gq = __builtin_fmaxf(gq, __shfl_xor(gq, o)); gk = __builtin_fmaxf(gk, __shfl_xor(gk, o)); gm = __builtin_fmaxf(gm, __shfl_xor(gm, o)); }
    const float shift_mla = 13.8564064606f * gq * gk * 1.44269504089f, shift_mem = 16.0f * gm * 1.44269504089f;
    const int xcc = (int)(xb_xcc_id() & 7u);
    for (;;) {
        __syncthreads();
        if (tid == 0) { int code = -1;
            for (int k = 0; k < 8; ++k) { const int xq = (xcc + k) & 7; const unsigned i = atomicAdd(qc + 64 * xq, 1u); if (i < 48u) { code = xq * 64 + (int)i; break; } }
            *slot = (unsigned)code; }
        __syncthreads();
        const int code = __builtin_amdgcn_readfirstlane((int)*slot); if (code < 0) break;
        const int xq = code >> 6, qi = code & 63, m = 15 - qi / 3, pos = qi % 3;
        const int hh = pos == 1 ? 8 + (xq >> 1) : xq, qb = pos == 0 ? 2 * m + 1 : (pos == 2 ? 2 * m : 2 * m + 1 - (xq & 1));
        att::attn_unit_sm3<192>(lds, (const bf16*)(ws + WS_QRAW) + hh * 192, NQB, (const bf16*)(ws + WS_KF) + hh * 192, NQB, (const bf16*)(ws + WS_KVRAW) + hh * 256 + 128, NKVB,
                                (bf16*)(ws + WS_OCAT) + 1536 + hh * 128, D, 256 * qb, 4 * qb + 4, 4 * qb + (wave >> 1), 0.07216878364870322f * 1.44269504089f, shift_mla, tid, lane, wave, (const float*)(ws + WS_ROPECS), a.in[10]);
    }
    for (;;) {
        const int u = next_unit(qc + 64 * 8, slot, tid); if (u >= 12 * 32) break;
        const int hh = u % 12, qb = 31 - u / 12;
        att::attn_unit<0, 128>(lds, proj + C_SBQ + hh * 128, NP, proj + C_SBK + hh * 128, NP, proj + C_SBV + hh * 128, NP,
                               (bf16*)(ws + WS_OCAT) + hh * 128, D, 256 * qb, 4 * qb + 3, -1, 4 * qb + 4, 4 * qb + (wave >> 1), 0.08838834764831845f * 1.44269504089f, 0.f, flags, tid, lane, wave);
    }
    for (;;) {
        const int u = next_unit(qc + 64 * 9, slot, tid); if (u >= 4 * 2 * 32) break;
        const int hh = u & 3, dvh = (u >> 2) & 1, qb = u >> 3;
        att::attn_unit<1, 256, true>(lds, proj + C_MEMQ + hh * 256, NP, (const bf16*)(ws + WS_MKF) + hh * 256, MEMW, (const bf16*)(ws + WS_MKV) + 1024 + hh * 256 + dvh * 128, 2048,
                               (bf16*)(ws + WS_OCAT) + 3072 + hh * 256 + dvh * 128, D, 256 * qb, 0, 1, 4, 1 << 20, 0.0625f * 1.44269504089f, shift_mem, flags, tid, lane, wave);
    }
    __syncthreads();
}

__global__ void __launch_bounds__(NWAVES * 64, 2) fwd(Args args) {
    extern __shared__ __attribute__((aligned(16))) unsigned char lds_raw[];
    LAS unsigned char* lds = (LAS unsigned char*)lds_raw;
    const int tid = threadIdx.x, lane = tid & 63, wave = __builtin_amdgcn_readfirstlane(tid >> 6);
    const int G = gridDim.x, bx = blockIdx.x;
    const int vcu = (G % 8 == 0) ? (bx % 8) * (G / 8) + bx / 8 : bx;
    const int gw = vcu * NWAVES + wave, NGW = G * NWAVES;
    unsigned char* ws = args.ws;
    for (int u = tid; u < (LDS_BYTES - LDSCTL_OFF) / 4; u += NWAVES * 64) ((LAS unsigned*)(lds + LDSCTL_OFF))[u] = 0u;
    __syncthreads();
    unsigned* barw = (unsigned*)(ws + WS_CTL) + CW_BAR + args.li * XCD_BAR_WORDS;
    XcdBarrier bar; bar.bar = barw; bar.x = 0; bar.st = nullptr;
    const int lo = args.ph_lo, hi = args.ph_hi;
    if (hi - lo > 1) bar = xcd_barrier_post(barw, (volatile LAS unsigned*)(lds + LDSCTL_OFF + 64));
#define IN(k) (lo <= (k) && (k) < hi)
#define SEAM(k) do { if (IN(k) && IN((k) + 1)) xcd_barrier(bar); } while (0)

    if (IN(0)) { p0_prologue(args, lds, gw, NGW, wave, lane); __syncthreads(); }
    SEAM(0);
    if (IN(1)) {
        { pg8::Gemm g{(const bf16*)(ws + WS_H), (const bf16*)(ws + WS_WIN), S, NP, D}; pg8::StaticOrder So; So.init(S, NP, G, bx);
          pg8::EpiProj E{(bf16*)(ws + WS_PROJ), NP, C_GATE / 256, (float*)(ws + WS_CTL + CTL_SSQ_OFF) + S, (float*)(ws + WS_CTL + CTL_SSQ_OFF) + 2 * S, C_CQ / 128, C_CKV / 128, C_CKV / 128, C_KPE / 128};
          pg8::gemm_phase<pg8::EpiProj, pg8::StaticOrder, true, true>(lds, g, So, E); }
        if (G == 256 && bx >= 128 && bx < 248) p1_deferred_convert(args, lds, (bx - 128) * NWAVES + wave, 120 * NWAVES, wave, lane);
        else if (G != 256) p1_deferred_convert(args, lds, gw, NGW, wave, lane);
        __syncthreads();
        { pg8::Gemm g{(const bf16*)(ws + WS_HM), (const bf16*)(ws + WS_WMEMKV), NMEM, 2048, D}; pg8::StaticOrder So; So.init(NMEM, 2048, G, G - 1 - bx);
          pg8::EpiProj E{(bf16*)(ws + WS_MKV), 2048, 1 << 30, nullptr, nullptr, 0, 0, 0, 0};
          pg8::gemm_phase<pg8::EpiProj, pg8::StaticOrder, true, true>(lds, g, So, E);
          for (int i = 0; ; ++i) { pg8::Unit u; if (!So.next(i, u)) break; if (u.pn < 4) mk_finalize_tile(args, u.pn, wave, lane); } }
    }
    SEAM(1);
    if (IN(3)) {
        const float* ssq = (const float*)(ws + WS_CTL + CTL_SSQ_OFF);
        { pg8::Gemm g{(const bf16*)(ws + WS_PROJ) + C_CKV, (const bf16*)(ws + WS_WKVB), S, NKVB, KVLORA, NP, 0}; pg8::StaticOrder So; So.init(S, NKVB, G, bx);
          pg8::EpiRowScale E{(bf16*)(ws + WS_KVRAW), NKVB, ssq + 2 * S, 1.0f / KVLORA, EPS};
          pg8::gemm_phase<pg8::EpiRowScale, pg8::StaticOrder, true, true>(lds, g, So, E);
          for (int i = 0; ; ++i) { pg8::Unit u; if (!So.next(i, u)) break; k_finalize_tile(args, u.pm, u.pn, wave, lane); } }
        { pg8::Gemm g{(const bf16*)(ws + WS_PROJ) + C_CQ, (const bf16*)(ws + WS_WQB), S, NQB, QLORA, NP, 0}; pg8::StaticOrder So; So.init(S, NQB, G, G - 1 - bx);
          pg8::EpiRowScale E{(bf16*)(ws + WS_QRAW), NQB, ssq + S, 1.0f / QLORA, EPS};
          pg8::gemm_phase<pg8::EpiRowScale, pg8::StaticOrder, true, true>(lds, g, So, E); }
    }
    SEAM(3);
    if (IN(5)) p5_attention(args, lds, tid, lane, wave, 0);
    SEAM(5);
    if (IN(6)) {
        pg8::Gemm g{(const bf16*)(ws + WS_OCAT), (const bf16*)(ws + WS_WCAT), S, D, D}; pg8::StaticOrder So; So.init(S, D, G, bx);
        pg8::EpiMergeSeg E{(const bf16*)(ws + WS_PROJ) + C_GATE, NP, D, (bf16*)(ws + WS_MERGED), D};
        pg8::gemm_phase<pg8::EpiMergeSeg, pg8::StaticOrder, true, true>(lds, g, So, E);
    }
    SEAM(6);
    if (IN(7)) {
        pg8::Gemm g{(const bf16*)(ws + WS_MERGED), (const bf16*)(ws + WS_WOUT), S, D, D}; pg8::StaticOrder So; So.init(S, D, G, bx);
        pg8::EpiWout E{args.in[0], (bf16*)(ws + WS_X1B), (bf16*)(ws + WS_XG), args.in[19], (float*)(ws + WS_CTL + CTL_SSQ_OFF), D};
        pg8::gemm_phase<pg8::EpiWout, pg8::StaticOrder, true, true>(lds, g, So, E);
    }
    if (IN(7)) tr_pipeline<1>(args, lds + wave * 8192, gw, NGW, lane);
    SEAM(7);
    if (IN(8)) {
        pg8::Gemm g{(const bf16*)(ws + WS_XG), (const bf16*)(ws + WS_WFF1), S, DFF, D}; pg8::StaticOrder So; So.init(S, DFF, G, bx);
        pg8::EpiFF1 E{(bf16*)(ws + WS_U), LDU, (const float*)(ws + WS_CTL + CTL_SSQ_OFF), 1.0f / D, EPS};
        pg8::gemm_phase<pg8::EpiFF1, pg8::StaticOrder, true, true>(lds, g, So, E);
    }
    if (IN(8)) tr_pipeline<2>(args, lds + wave * 8192, gw, NGW, lane);
    SEAM(8);
    if (IN(9)) {
        pg8::Gemm g{(const bf16*)(ws + WS_U), (const bf16*)(ws + WS_WFF2), S, D, DFF, LDU, LDU}; pg8::StaticOrder So; So.init(S, D, G, bx, P9_WGM);
        pg8::EpiAccF32 E{args.out, (const bf16*)(ws + WS_X1B), D};
        pg8::gemm_phase<pg8::EpiAccF32, pg8::StaticOrder, true, true>(lds, g, So, E);
    }
#undef IN
#undef SEAM
}

extern "C" void kernel_launch(void* const* d_in, const int* in_sizes, int n_in, void* d_out, int out_size, void* d_ws, size_t ws_size, hipStream_t stream) {
    static int grid = 0;
    if (grid == 0) {
        if (n_in != 22 || in_sizes[0] != S * D || out_size != S * D || ws_size < WS_END) {
            fprintf(stderr, "kernel_launch: unexpected shapes (n_in %d, in0 %d, out %d, ws %zu < %zu); nothing launched\n", n_in, n_in > 0 ? in_sizes[0] : -1, out_size, ws_size, (size_t)WS_END); grid = -1; return; }
        int dev = 0, cus = 0, per_cu = 0;
        if (hipGetDevice(&dev) != hipSuccess || hipDeviceGetAttribute(&cus, hipDeviceAttributeMultiprocessorCount, dev) != hipSuccess) { grid = -1; return; }
        if (hipFuncSetAttribute((const void*)fwd, hipFuncAttributeMaxDynamicSharedMemorySize, LDS_BYTES) != hipSuccess) { fprintf(stderr, "kernel_launch: hipFuncSetAttribute failed\n"); grid = -1; return; }
        if (hipOccupancyMaxActiveBlocksPerMultiprocessor(&per_cu, (const void*)fwd, NWAVES * 64, LDS_BYTES) != hipSuccess || per_cu < 1)
            fprintf(stderr, "kernel_launch: note: occupancy query reports %d workgroups per CU\n", per_cu);
        (void)hipGetLastError();
        grid = cus;
    }
    if (grid < 0) return;
    if (hipMemsetAsync((char*)d_ws + WS_CTL, 0, CTL_ZERO_BYTES, stream) != hipSuccess) { fprintf(stderr, "kernel_launch: memset failed\n"); return; }
    Args a{};
    for (int i = 0; i < 22; ++i) a.in[i] = (const float*)d_in[i];
    a.out = (float*)d_out; a.ws = (unsigned char*)d_ws;
    for (int li = 0; li < NLAUNCH; ++li) {
        a.ph_lo = (NLAUNCH == 1) ? 0 : li; a.ph_hi = (NLAUNCH == 1) ? NPH : li + 1; a.li = (NLAUNCH == 1) ? 0 : 0; a.pad = 0;
        hipLaunchKernelGGL(fwd, dim3(grid), dim3(NWAVES * 64), LDS_BYTES, stream, a);
        const hipError_t le = hipPeekAtLastError();
        if (le != hipSuccess) { fprintf(stderr, "kernel_launch: launch %d failed: %s\n", li, hipGetErrorName(le)); break; }
    }
}
```
